# Optimizing an MI355X kernel written in HIP

```python
import jax, jax.numpy as jnp
from jax import lax
import numpy as np


D_MODEL = 2048
BATCH = 4
SEQ = 4096
DEPTH = 2

GRID_W = 64
CTX_LEN = 256
N_HEADS = 8
N_KV_HEADS = 2
HEAD_DIM = 128
ATTN_W = N_HEADS * HEAD_DIM
KV_W = N_KV_HEADS * HEAD_DIM
Q_BLOCK = 128
ROPE_THETA = 10000.0
ROPE_PAIRS = HEAD_DIM // 4
D_RNN = 1024
RNN_BLOCKS = 8
RNN_BLOCK_W = D_RNN // RNN_BLOCKS
CONV_W = 4
RG_C = 8.0
AR_IN = ATTN_W + 2 * KV_W + 2 * D_RNN
AR_OUT = ATTN_W + D_RNN
D_GM = 2048
GM_GROUPS = 16
GM_GROUP_W = D_GM // GM_GROUPS
CHUNK = 128
D_FF = 4 * D_MODEL
EPS = 1e-6
N_EVEN = (DEPTH + 1) // 2
N_ODD = DEPTH // 2

kernel_name = 'hybrid_attn_rglru_chunkgmlp_diffusion'


def rms_norm(x, g):
    xf = x.astype(jnp.float32)
    y = xf * lax.rsqrt(jnp.mean(xf * xf, axis=-1, keepdims=True) + EPS)
    return (y * g.astype(jnp.float32)).astype(x.dtype)


def layer_norm(x, g, b):
    xf = x.astype(jnp.float32)
    mu = jnp.mean(xf, axis=-1, keepdims=True)
    xc = xf - mu
    y = xc * lax.rsqrt(jnp.mean(xc * xc, axis=-1, keepdims=True) + EPS)
    return (y * g.astype(jnp.float32) + b.astype(jnp.float32)).astype(x.dtype)


def modulate(h, shift, scale):
    return h * (1 + scale) + shift


def axial_angles(n):
    rows = n // GRID_W
    r_idx, c_idx = jnp.meshgrid(jnp.arange(rows), jnp.arange(GRID_W), indexing='ij')
    r_idx = r_idx.reshape(-1).astype(jnp.float32)
    c_idx = c_idx.reshape(-1).astype(jnp.float32)
    freqs = ROPE_THETA ** (-jnp.arange(ROPE_PAIRS, dtype=jnp.float32) / ROPE_PAIRS)
    return r_idx[:, None] * freqs, c_idx[:, None] * freqs


def rope_1d(x, ang):
    x1, x2 = jnp.split(x.astype(jnp.float32), 2, axis=-1)
    cos = jnp.cos(ang)[None, :, None, :]
    sin = jnp.sin(ang)[None, :, None, :]
    return jnp.concatenate([x1 * cos - x2 * sin, x2 * cos + x1 * sin], axis=-1)


def rope_2d(x, ang_row, ang_col):
    half = HEAD_DIM // 2
    out = jnp.concatenate([rope_1d(x[..., :half], ang_row), rope_1d(x[..., half:], ang_col)], axis=-1)
    return out.astype(x.dtype)


def gqa_attend(q, k, v):
    bsz, n = q.shape[0], q.shape[1]
    nb = n // Q_BLOCK
    groups = N_HEADS // N_KV_HEADS
    scale = HEAD_DIM ** -0.5
    qb = q.reshape(bsz, nb, Q_BLOCK, N_KV_HEADS, groups, HEAD_DIM).transpose(1, 0, 2, 3, 4, 5)

    def one_block(qi):
        s = jnp.einsum('bqkgd,btkd->bkgqt', qi, k).astype(jnp.float32) * scale
        p = jax.nn.softmax(s, axis=-1).astype(v.dtype)
        return jnp.einsum('bkgqt,btkd->bqkgd', p, v)

    o = lax.map(one_block, qb)
    return o.transpose(1, 0, 2, 3, 4, 5).reshape(bsz, n, N_HEADS * HEAD_DIM)


def centred_dwconv(x, w, b):
    n = x.shape[1]
    left = CONV_W // 2
    xp = jnp.pad(x, ((0, 0), (left, CONV_W - 1 - left), (0, 0)))
    y = b
    for j in range(CONV_W):
        y = y + xp[:, j:j + n] * w[j]
    return y


def block_diag(x, w, b):
    xb = x.reshape(x.shape[0], x.shape[1], RNN_BLOCKS, RNN_BLOCK_W)
    return jnp.einsum('bsnc,ncd->bsnd', xb, w).reshape(x.shape) + b


def rglru_direction(x, wa, ba, wx, bx, lam, h0, reverse):
    r = jax.nn.sigmoid(block_diag(x, wa, ba).astype(jnp.float32))
    i = jax.nn.sigmoid(block_diag(x, wx, bx).astype(jnp.float32))
    log_a = -RG_C * r * jax.nn.softplus(-lam.astype(jnp.float32))
    a = jnp.exp(log_a)
    b = jnp.sqrt(-jnp.expm1(2.0 * log_a)) * (i * x.astype(jnp.float32))

    def combine(lhs, rhs):
        return (lhs[0] * rhs[0], rhs[0] * lhs[1] + rhs[1])

    a_cum, h = lax.associative_scan(combine, (a, b), reverse=reverse, axis=1)
    h = h + a_cum * h0[:, None, :]
    final = h[:, 0] if reverse else h[:, -1]
    return h, final


def mix_attn_rglru(hl, hc, w_in, q_g, k_g, conv_w, conv_b, wa, ba, wx, bx, lam, w_out, need_ctx):
    s1 = ATTN_W
    s2 = s1 + KV_W
    s3 = s2 + KV_W
    s4 = s3 + D_RNN

    def project(h):
        bsz, n = h.shape[0], h.shape[1]
        q, k, v, xr, gr = jnp.split(h @ w_in, [s1, s2, s3, s4], axis=-1)
        q = rms_norm(q.reshape(bsz, n, N_HEADS, HEAD_DIM), q_g)
        k = rms_norm(k.reshape(bsz, n, N_KV_HEADS, HEAD_DIM), k_g)
        v = v.reshape(bsz, n, N_KV_HEADS, HEAD_DIM)
        xr = centred_dwconv(xr, conv_w, conv_b)
        return q, k, v, xr, gr

    ql, kl, vl, xl, gl = project(hl)
    qc, kc, vc, xc, gc = project(hc)

    ang_r, ang_c = axial_angles(hl.shape[1])
    ql = rope_2d(ql, ang_r, ang_c)
    kl = rope_2d(kl, ang_r, ang_c)
    k_all = jnp.concatenate([kc, kl], axis=1)
    v_all = jnp.concatenate([vc, vl], axis=1)
    attn_l = gqa_attend(ql, k_all, v_all)

    zeros = jnp.zeros((hc.shape[0], D_RNN), jnp.float32)
    hcf, fin_f = rglru_direction(xc, wa[0], ba[0], wx[0], bx[0], lam[0], zeros, False)
    hcb, fin_b = rglru_direction(xc, wa[1], ba[1], wx[1], bx[1], lam[1], zeros, True)
    hlf, _ = rglru_direction(xl, wa[0], ba[0], wx[0], bx[0], lam[0], fin_f, False)
    hlb, _ = rglru_direction(xl, wa[1], ba[1], wx[1], bx[1], lam[1], fin_b, True)
    rnn_l = ((hlf + hlb) * jax.nn.gelu(gl.astype(jnp.float32))).astype(hl.dtype)
    out_l = jnp.concatenate([attn_l, rnn_l], axis=-1) @ w_out

    out_c = None
    if need_ctx:
        attn_c = gqa_attend(qc, kc, vc)
        rnn_c = ((hcf + hcb) * jax.nn.gelu(gc.astype(jnp.float32))).astype(hc.dtype)
        out_c = jnp.concatenate([attn_c, rnn_c], axis=-1) @ w_out
    return out_l, out_c


def chunk_gmlp(h, w_in, b_in, v_g, v_b, w_sp, b_sp, w_out):
    bsz, n = h.shape[0], h.shape[1]
    z = jax.nn.gelu(h @ w_in + b_in)
    u, v = jnp.split(z, 2, axis=-1)
    v = layer_norm(v, v_g, v_b)
    v = v.reshape(bsz, n // CHUNK, CHUNK, GM_GROUPS, GM_GROUP_W)
    sv = jnp.einsum('gpq,bcqgd->bcpgd', w_sp, v) + b_sp.T[None, None, :, :, None]
    return (u * sv.reshape(bsz, n, D_GM)) @ w_out


def sq_relu_mlp(h, w1, w2):
    return jnp.square(jax.nn.relu(h @ w1)) @ w2


def setup_inputs(seed: int = 0) -> dict:
    key = jax.random.key(seed)
    ks = jax.random.split(key, 32)
    f32 = jnp.float32
    D = D_MODEL

    def nrm(k, shape, scale):
        return jax.random.normal(k, shape, f32) * scale

    lam_u = jax.random.uniform(ks[20], (N_EVEN, 2, D_RNN), f32, 0.9, 0.999)
    a0 = lam_u ** (1.0 / RG_C)
    return {
        'x': nrm(ks[0], (BATCH, SEQ, D), 1.0),
        'c': nrm(ks[1], (BATCH, D), 1.0),
        'ctx': nrm(ks[2], (BATCH, CTX_LEN, D), 1.0),
        'c_ctx': nrm(ks[3], (D,), 1.0),
        'w_mod': nrm(ks[4], (DEPTH, D, 6 * D), 0.5 * D ** -0.5),
        'b_mod': nrm(ks[5], (DEPTH, 6 * D), 0.02),
        'norm_g': 1.0 + nrm(ks[6], (DEPTH, 4, D), 0.02),
        'w_ff_in': nrm(ks[7], (DEPTH, D, D_FF), D ** -0.5),
        'w_ff_out': nrm(ks[8], (DEPTH, D_FF, D), D_FF ** -0.5),
        'ar_w_in': nrm(ks[9], (N_EVEN, D, AR_IN), D ** -0.5),
        'ar_q_g': 1.0 + nrm(ks[10], (N_EVEN, HEAD_DIM), 0.02),
        'ar_k_g': 1.0 + nrm(ks[11], (N_EVEN, HEAD_DIM), 0.02),
        'ar_conv_w': nrm(ks[12], (N_EVEN, CONV_W, D_RNN), CONV_W ** -0.5),
        'ar_conv_b': nrm(ks[13], (N_EVEN, D_RNN), 0.02),
        'ar_wa': nrm(ks[14], (N_EVEN, 2, RNN_BLOCKS, RNN_BLOCK_W, RNN_BLOCK_W), RNN_BLOCK_W ** -0.5),
        'ar_ba': nrm(ks[15], (N_EVEN, 2, D_RNN), 0.02),
        'ar_wx': nrm(ks[16], (N_EVEN, 2, RNN_BLOCKS, RNN_BLOCK_W, RNN_BLOCK_W), RNN_BLOCK_W ** -0.5),
        'ar_bx': nrm(ks[17], (N_EVEN, 2, D_RNN), 0.02),
        'ar_lambda': jnp.log(a0) - jnp.log1p(-a0),
        'ar_w_out': nrm(ks[18], (N_EVEN, AR_OUT, D), AR_OUT ** -0.5),
        'gm_w_in': nrm(ks[19], (N_ODD, D, 2 * D_GM), D ** -0.5),
        'gm_b_in': nrm(ks[21], (N_ODD, 2 * D_GM), 0.02),
        'gm_v_g': 1.0 + nrm(ks[22], (N_ODD, D_GM), 0.02),
        'gm_v_b': nrm(ks[23], (N_ODD, D_GM), 0.02),
        'gm_w_sp': nrm(ks[24], (N_ODD, GM_GROUPS, CHUNK, CHUNK), CHUNK ** -0.5),
        'gm_b_sp': 1.0 + nrm(ks[25], (N_ODD, GM_GROUPS, CHUNK), 0.02),
        'gm_w_out': nrm(ks[26], (N_ODD, D_GM, D), D_GM ** -0.5),
    }


def reference(x, c, ctx, c_ctx, w_mod, b_mod, norm_g, w_ff_in, w_ff_out, ar_w_in, ar_q_g, ar_k_g, ar_conv_w, ar_conv_b, ar_wa, ar_ba, ar_wx, ar_bx, ar_lambda, ar_w_out, gm_w_in, gm_b_in, gm_v_g, gm_v_b, gm_w_sp, gm_b_sp, gm_w_out):
    xl, xc = x, ctx
    s_c = jax.nn.silu(c)
    s_ctx = jax.nn.silu(c_ctx)
    for i in range(DEPTH):
        j = i // 2
        need_ctx = any(l % 2 == 0 for l in range(i + 1, DEPTH))
        g = norm_g[i]
        ml = jnp.split((s_c @ w_mod[i] + b_mod[i])[:, None, :], 6, axis=-1)
        mc = jnp.split((s_ctx @ w_mod[i] + b_mod[i])[None, None, :], 6, axis=-1)
        hl = modulate(rms_norm(xl, g[0]), ml[0], ml[1])
        oc = None
        if i % 2 == 0:
            hc = modulate(rms_norm(xc, g[0]), mc[0], mc[1])
            ol, oc = mix_attn_rglru(hl, hc, ar_w_in[j], ar_q_g[j], ar_k_g[j], ar_conv_w[j], ar_conv_b[j],
                                    ar_wa[j], ar_ba[j], ar_wx[j], ar_bx[j], ar_lambda[j], ar_w_out[j], need_ctx)
        else:
            ol = chunk_gmlp(hl, gm_w_in[j], gm_b_in[j], gm_v_g[j], gm_v_b[j], gm_w_sp[j], gm_b_sp[j], gm_w_out[j])
            if need_ctx:
                hc = modulate(rms_norm(xc, g[0]), mc[0], mc[1])
                oc = chunk_gmlp(hc, gm_w_in[j], gm_b_in[j], gm_v_g[j], gm_v_b[j], gm_w_sp[j], gm_b_sp[j], gm_w_out[j])
        xl = xl + ml[2] * rms_norm(ol, g[1])
        hl = modulate(rms_norm(xl, g[2]), ml[3], ml[4])
        xl = xl + ml[5] * rms_norm(sq_relu_mlp(hl, w_ff_in[i], w_ff_out[i]), g[3])
        if need_ctx:
            xc = xc + mc[2] * rms_norm(oc, g[1])
            hc = modulate(rms_norm(xc, g[2]), mc[3], mc[4])
            xc = xc + mc[5] * rms_norm(sq_relu_mlp(hc, w_ff_in[i], w_ff_out[i]), g[3])
    return xl
```

```cpp
#include <hip/hip_runtime.h>
#include <hip/hip_cooperative_groups.h>
#include <hip/hip_bf16.h>
#include <cstdio>
#include <cstdint>
namespace pg8 {
#define PG8_LAS __attribute__((address_space(3)))
typedef unsigned short bf16_t;
typedef short bf16x8 __attribute__((ext_vector_type(8)));
typedef float f32x4 __attribute__((ext_vector_type(4)));
typedef unsigned u32x4 __attribute__((ext_vector_type(4)));
constexpr int BM = 256, BK = 64, HALF = 128, HTB = HALF * BK * 2  , STAGE_BYTES = 8 * HTB, NXCD = 8, WGM = 8;

__host__ __device__ __forceinline__ int lds_byte(int r, int c) { const int st = (r >> 4) * 2 + (c >> 5), rr = r & 15, cc = c & 31, ob = rr * 64 + cc * 2; return st * 1024 + (ob ^ (((ob >> 9) & 1) << 5)); }
__host__ __device__ __forceinline__ void stage_rc(int b, int& R, int& C) { const int st = b / 1024, sb = b % 1024, swz = sb ^ (((sb >> 9) & 1) << 5); R = (st >> 1) * 16 + swz / 64; C = (st & 1) * 32 + (swz % 64) / 2; }
__host__ __device__ __forceinline__ int perm32(int rho) { const int n = rho >> 4, i = rho & 15; return 8 * (i >> 2) + 4 * n + (i & 3); }

struct Unit { int pm, pn; };
struct Gemm { const bf16_t* A; const bf16_t* Bt; int M, N, K; };

struct StaticOrder {
    int nM, nN, nwg, G, c;
    __host__ __device__ void init(int M, int N, int G_, int c_) { nM = M / BM; nN = N / BM; nwg = nM * nN; G = G_; c = c_; }
    __host__ __device__ bool next(int i, Unit& u) const {
        const long L = (long)i * G + c; if (L >= nwg) return false;
        int wgid = (int)L; { const int q = nwg / NXCD, r = nwg % NXCD, xcd = wgid % NXCD, off = wgid / NXCD; wgid = (xcd < r ? xcd * (q + 1) : r * (q + 1) + (xcd - r) * q) + off; }
        const int nig = WGM * nN, gid = wgid / nig, fm = gid * WGM, gsz = (nM - fm) < WGM ? (nM - fm) : WGM;
        u.pm = fm + ((wgid % nig) % gsz); u.pn = (wgid % nig) / gsz; return true;
    }
    __device__ __forceinline__ void a_ready(const Unit&) const {}
    __device__ __forceinline__ void done(const Unit&) const {}
};

__device__ __forceinline__ unsigned cvt_pk_bf16(float lo, float hi) { unsigned r; asm volatile("v_cvt_pk_bf16_f32 %0, %1, %2" : "=v"(r) : "v"(lo), "v"(hi)); return r; }
typedef float f32x2 __attribute__((ext_vector_type(2)));
__device__ __forceinline__ f32x2 gelu_pk(f32x2 v) {
    const f32x2 av = __builtin_elementwise_abs(v), d = av * 0.2316418882f + 1.0f;
    f32x2 t; t.x = __builtin_amdgcn_rcpf(d.x); t.y = __builtin_amdgcn_rcpf(d.y);
    f32x2 q = t * 0.5307027145f + (-0.7265760135f); q = q * t + 0.7107068705f; q = q * t + (-0.142248368f); q = q * t + 0.127414796f; q = q * t;
    const f32x2 s = (v * v) * (-0.72134752044f);
    f32x2 e; e.x = __builtin_amdgcn_exp2f(s.x); e.y = __builtin_amdgcn_exp2f(s.y);
    const f32x2 m = v * (q * e), r = v - m;
    f32x2 o; o.x = v.x < 0.f ? m.x : r.x; o.y = v.y < 0.f ? m.y : r.y; return o;
}

__device__ __forceinline__ float gelu_tanh(float x) {
    const float t = 0.7978845608028654f * (x + 0.044715f * x * x * x);
    return x * __builtin_amdgcn_rcpf(1.0f + __builtin_amdgcn_exp2f(-2.8853900817779268f * t));
}
template <int ACT  > struct EpiAct {
    static constexpr bool PERM = true, AFTER_DRAIN = false;
    bf16_t* O; int ldc; const float* bias; float* part;
    __device__ __forceinline__ void operator()(const f32x4 (&acc)[2][2][4][2], const Unit& u, int wr, int wc, int fr, int fq) const {
        const int row0 = u.pm * BM + wr * 64 + fr; const int col0 = u.pn * BM + wc * 32 + 8 * fq;
        f32x4 bv[2][2];
#pragma unroll
        for (int bj = 0; bj < 2; ++bj)
#pragma unroll
            for (int n = 0; n < 2; ++n) bv[bj][n] = bias ? *(const f32x4*)(bias + col0 + bj * HALF + 4 * n) : (f32x4){0.f, 0.f, 0.f, 0.f};
#pragma unroll
        for (int ai = 0; ai < 2; ++ai)
#pragma unroll
            for (int m = 0; m < 4; ++m) { bf16_t* rowp = O + (size_t)(row0 + ai * HALF + m * 16) * ldc + col0; float s1 = 0.f, s2 = 0.f;
#pragma unroll
                for (int bj = 0; bj < 2; ++bj) { f32x4 v0 = acc[ai][bj][m][0] + bv[bj][0], v1 = acc[ai][bj][m][1] + bv[bj][1];
                    if (ACT == 2) {
#pragma unroll
                        for (int e = 0; e < 4; ++e) { float a = fmaxf(v0[e], 0.f), b = fmaxf(v1[e], 0.f); v0[e] = a * a; v1[e] = b * b; } }
                    if (ACT == 3) {
#pragma unroll
                        for (int e = 0; e < 4; ++e) { v0[e] = gelu_tanh(v0[e]); v1[e] = gelu_tanh(v1[e]); s1 += v0[e] + v1[e]; s2 += v0[e] * v0[e] + v1[e] * v1[e]; } }
                    u32x4 w; w.x = cvt_pk_bf16(v0[0], v0[1]); w.y = cvt_pk_bf16(v0[2], v0[3]); w.z = cvt_pk_bf16(v1[0], v1[1]); w.w = cvt_pk_bf16(v1[2], v1[3]);
                    *(u32x4*)(rowp + bj * HALF) = w; }
                if (ACT == 3 && part && u.pn >= 8) { s1 += __shfl_xor(s1, 16); s1 += __shfl_xor(s1, 32); s2 += __shfl_xor(s2, 16); s2 += __shfl_xor(s2, 32);
                    if (fq == 0) *(f32x2*)(part + (((size_t)(row0 + ai * HALF + m * 16) * 8 + (u.pn - 8)) * 4 + wc) * 2) = (f32x2){s1, s2}; } }
    }
};
template <class Epi, class Sched, bool ALIGN_EPI = false, bool SP2 = false>
__device__ __forceinline__ void gemm_phase(PG8_LAS unsigned char* lds, const Gemm g, const Sched& S, const Epi& E) {
    const int tid = threadIdx.x, wid = __builtin_amdgcn_readfirstlane(tid >> 6), lane = tid & 63, wr = wid >> 2, wc = wid & 3, fr = lane & 15, fq = lane >> 4;
    const int K = g.K, nt = K / BK;
    unsigned voffA[2], voffB[2];
#pragma unroll
    for (int i = 0; i < 2; ++i) { int R, C; stage_rc(tid * 16 + i * 8192, R, C); const int Rb = Epi::PERM ? ((R & ~31) + perm32(R & 31)) : R;
        voffA[i] = (unsigned)(R * K + C) * 2u; voffB[i] = (unsigned)(Rb * K + C) * 2u; }
    const size_t kstep = (size_t)(BK * 2);
    const size_t hstep = (size_t)HALF * K * 2;
    const size_t tstep = 2 * hstep;
    const unsigned ldsw = (unsigned)wid * 1024u;
    const int aoff = lds_byte(wr * 64 + fr, fq * 8), boff = lds_byte(wc * 32 + fr, fq * 8);
#define PG8_SA(b, h) (((b) * 2 + (h)) * HTB)
#define PG8_SB(b, h) ((4 + (b) * 2 + (h)) * HTB)
#define PG8_STAGE(bufoff, gbase, voff) do { _Pragma("unroll") for (int _i = 0; _i < 2; ++_i) \
        __builtin_amdgcn_global_load_lds((const unsigned*)((const char*)(gbase) + (voff)[_i]), (PG8_LAS unsigned*)(lds + (bufoff) + ldsw + _i * 8192), 16, 0, 0); } while (0)
#define PG8_LDA(dst, b, h) do { _Pragma("unroll") for (int m = 0; m < 4; ++m) _Pragma("unroll") for (int k = 0; k < 2; ++k) dst[m][k] = *(const PG8_LAS bf16x8*)(lds + PG8_SA(b, h) + aoff + m * 2048 + k * 1024); } while (0)
#define PG8_LDB(dst, b, h) do { _Pragma("unroll") for (int n = 0; n < 2; ++n) _Pragma("unroll") for (int k = 0; k < 2; ++k) dst[n][k] = *(const PG8_LAS bf16x8*)(lds + PG8_SB(b, h) + boff + n * 2048 + k * 1024); } while (0)
#define PG8_MMA(ai, bj, At, Bt) do { __builtin_amdgcn_s_setprio(1); _Pragma("unroll") for (int m = 0; m < 4; ++m) _Pragma("unroll") for (int n = 0; n < 2; ++n) _Pragma("unroll") for (int k = 0; k < 2; ++k) \
        acc[ai][bj][m][n] = __builtin_amdgcn_mfma_f32_16x16x32_bf16(Bt[n][k], At[m][k], acc[ai][bj][m][n], 0, 0, 0); __builtin_amdgcn_s_setprio(0); } while (0)
#define PG8_WAIT_V(n) asm volatile("s_waitcnt vmcnt(" #n ")" ::: "memory")
#define PG8_WAIT_L(n) asm volatile("s_waitcnt lgkmcnt(" #n ")" ::: "memory")
#define PG8_BAR __builtin_amdgcn_s_barrier()
#define PG8_SCHED __builtin_amdgcn_sched_barrier(0)
    Unit cur, nxt; int ui = 0;
    if (!S.next(0, cur)) return;
    f32x4 acc[2][2][4][2];
#pragma unroll
    for (int a = 0; a < 2; ++a)
#pragma unroll
        for (int b = 0; b < 2; ++b)
#pragma unroll
            for (int m = 0; m < 4; ++m)
#pragma unroll
                for (int n = 0; n < 2; ++n) acc[a][b][m][n] = (f32x4){0.f, 0.f, 0.f, 0.f};
    bf16x8 At[4][2], B0[2][2], B1[2][2];
    const char* cA = (const char*)g.A + (size_t)cur.pm * tstep; const char* cB = (const char*)g.Bt + (size_t)cur.pn * tstep;
    S.a_ready(cur);
    if constexpr (SP2) {
        PG8_STAGE(PG8_SB(0, 0), cB, voffB); PG8_STAGE(PG8_SB(0, 1), cB + hstep, voffB); PG8_STAGE(PG8_SA(0, 0), cA, voffA); PG8_STAGE(PG8_SA(0, 1), cA + hstep, voffA);
        if (wr == 1) PG8_BAR;
        PG8_WAIT_V(2); PG8_BAR;
        PG8_STAGE(PG8_SB(1, 0), cB + kstep, voffB); PG8_STAGE(PG8_SA(1, 0), cA + kstep, voffA); PG8_STAGE(PG8_SB(1, 1), cB + hstep + kstep, voffB);
        PG8_WAIT_V(6); PG8_BAR;
    } else {
        PG8_STAGE(PG8_SB(0, 0), cB, voffB); PG8_STAGE(PG8_SA(0, 0), cA, voffA); PG8_STAGE(PG8_SB(0, 1), cB + hstep, voffB); PG8_STAGE(PG8_SA(0, 1), cA + hstep, voffA);
        if (wr == 1) PG8_BAR;
        PG8_WAIT_V(4); PG8_BAR;
        PG8_STAGE(PG8_SB(1, 0), cB + kstep, voffB); PG8_STAGE(PG8_SA(1, 0), cA + kstep, voffA); PG8_STAGE(PG8_SB(1, 1), cB + hstep + kstep, voffB);
        PG8_WAIT_V(6); PG8_BAR;
    }
    for (;;) {
        const bool has_next = S.next(ui + 1, nxt);
        const char* nA = has_next ? (const char*)g.A + (size_t)nxt.pm * tstep : cA; const char* nB = has_next ? (const char*)g.Bt + (size_t)nxt.pn * tstep : cB;
        for (int t = 0; t < nt; t += 2) {
            const bool last = (t == nt - 2);
            const char* a1 = cA + (size_t)(t + 1) * kstep;
            const char* a2 = last ? nA : cA + (size_t)(t + 2) * kstep; const char* b2 = last ? nB : cB + (size_t)(t + 2) * kstep;
            const char* a3 = a2 + kstep; const char* b3 = b2 + kstep;
            if (last && has_next) S.a_ready(nxt);
            if constexpr (SP2) {
            PG8_LDB(B0, 0, 0); PG8_LDB(B1, 0, 1); PG8_SCHED; PG8_LDA(At, 0, 0); PG8_STAGE(PG8_SA(1, 1), a1 + hstep, voffA);
            PG8_WAIT_V(8); PG8_WAIT_L(0); PG8_BAR; PG8_MMA(0, 0, At, B0); PG8_MMA(0, 1, At, B1); PG8_BAR; PG8_SCHED;
            PG8_LDA(At, 0, 1); PG8_STAGE(PG8_SB(0, 0), b2, voffB); PG8_STAGE(PG8_SB(0, 1), b2 + hstep, voffB); PG8_STAGE(PG8_SA(0, 0), a2, voffA);
            PG8_WAIT_V(8); PG8_WAIT_L(0); PG8_BAR; PG8_MMA(1, 0, At, B0); PG8_MMA(1, 1, At, B1); PG8_BAR; PG8_SCHED;
            PG8_LDB(B0, 1, 0); PG8_LDB(B1, 1, 1); PG8_SCHED; PG8_LDA(At, 1, 0); PG8_STAGE(PG8_SA(0, 1), a2 + hstep, voffA);
            PG8_WAIT_V(8); PG8_WAIT_L(0); PG8_BAR; PG8_MMA(0, 0, At, B0); PG8_MMA(0, 1, At, B1); PG8_BAR; PG8_SCHED;
            PG8_LDA(At, 1, 1); PG8_STAGE(PG8_SB(1, 0), b3, voffB); PG8_STAGE(PG8_SB(1, 1), b3 + hstep, voffB); PG8_STAGE(PG8_SA(1, 0), a3, voffA);
            PG8_WAIT_V(8); PG8_WAIT_L(0); PG8_BAR; PG8_MMA(1, 0, At, B0); PG8_MMA(1, 1, At, B1); PG8_BAR; PG8_SCHED;
            } else {
            PG8_LDB(B0, 0, 0); PG8_SCHED; PG8_LDA(At, 0, 0); PG8_STAGE(PG8_SA(1, 1), a1 + hstep, voffA);
            PG8_WAIT_L(8); PG8_BAR; PG8_WAIT_L(0); PG8_MMA(0, 0, At, B0); PG8_BAR; PG8_SCHED;
            PG8_LDB(B1, 0, 1); PG8_STAGE(PG8_SB(0, 0), b2, voffB);
            PG8_BAR; PG8_WAIT_L(0); PG8_MMA(0, 1, At, B1); PG8_BAR;
            PG8_LDA(At, 0, 1); PG8_STAGE(PG8_SA(0, 0), a2, voffA);
            PG8_BAR; PG8_WAIT_L(0); PG8_MMA(1, 0, At, B0); PG8_BAR; PG8_SCHED;
            PG8_STAGE(PG8_SB(0, 1), b2 + hstep, voffB);
            PG8_WAIT_V(6); PG8_BAR; PG8_MMA(1, 1, At, B1); PG8_BAR;
            PG8_LDB(B0, 1, 0); PG8_SCHED; PG8_LDA(At, 1, 0); PG8_STAGE(PG8_SA(0, 1), a2 + hstep, voffA);
            PG8_WAIT_L(8); PG8_BAR; PG8_WAIT_L(0); PG8_MMA(0, 0, At, B0); PG8_BAR; PG8_SCHED;
            PG8_LDB(B1, 1, 1); PG8_STAGE(PG8_SB(1, 0), b3, voffB);
            PG8_BAR; PG8_WAIT_L(0); PG8_MMA(0, 1, At, B1); PG8_BAR;
            PG8_LDA(At, 1, 1); PG8_STAGE(PG8_SA(1, 0), a3, voffA);
            PG8_BAR; PG8_WAIT_L(0); PG8_MMA(1, 0, At, B0); PG8_BAR; PG8_SCHED;
            PG8_STAGE(PG8_SB(1, 1), b3 + hstep, voffB);
            PG8_WAIT_V(6); PG8_BAR; PG8_MMA(1, 1, At, B1); PG8_BAR;
            }
        }
        if constexpr (ALIGN_EPI) { if (wr == 0) PG8_BAR; }
        if constexpr (!Epi::AFTER_DRAIN) { E(acc, cur, wr, wc, fr, fq); S.done(cur); }
        if (!has_next) break;
#pragma unroll
        for (int a = 0; a < 2; ++a)
#pragma unroll
            for (int b = 0; b < 2; ++b)
#pragma unroll
                for (int m = 0; m < 4; ++m)
#pragma unroll
                    for (int n = 0; n < 2; ++n) acc[a][b][m][n] = (f32x4){0.f, 0.f, 0.f, 0.f};
        cur = nxt; cA = nA; cB = nB; ++ui;
        if constexpr (ALIGN_EPI) { if (wr == 1) PG8_BAR; }
    }
    PG8_WAIT_V(0);
    if constexpr (!ALIGN_EPI) { if (wr == 0) PG8_BAR; }
    PG8_BAR;
    if constexpr (Epi::AFTER_DRAIN) { E.fused(acc, cur, wr, wc, fr, fq, lds, wid, lane); S.done(cur); }
#undef PG8_SA
#undef PG8_SB
#undef PG8_STAGE
#undef PG8_LDA
#undef PG8_LDB
#undef PG8_MMA
#undef PG8_WAIT_V
#undef PG8_WAIT_L
#undef PG8_BAR
#undef PG8_SCHED
}
}
namespace att {
using bf16 = __hip_bfloat16;
constexpr int   D = 128, NW = 8, QBLK = 32, KVBLK = 64;
constexpr float SCALE = 0.088388347648318440f;
constexpr float THR = 8.f;
constexpr int SDEPTH = 2;
constexpr int LDQ = 3584, LDK = 3584, LDO = 2048;
constexpr size_t SHM_V = KVBLK * D * 2, SHM_K = KVBLK * D * 2, SHM_ATTN = 2 * SHM_V + 2 * SHM_K + NW * 64 * 4;
using bf16x8 = __attribute__((ext_vector_type(8))) short;
using s16x4  = __attribute__((ext_vector_type(4))) short;
using f32x16 = __attribute__((ext_vector_type(16))) float;
using f32x8  = __attribute__((ext_vector_type(8))) float;
using u32x4  = __attribute__((ext_vector_type(4))) unsigned;
#define KSWZ(row, colB) ((row) * 256 + ((colB) ^ (((row) & 7) << 4)))
#define SBAR() __builtin_amdgcn_sched_barrier(0)
__device__ __forceinline__ int crow(int r, int hi) { return (r & 3) + 8 * (r >> 2) + 4 * hi; }
__device__ __forceinline__ unsigned cvtpk(float lo, float hi) {
  unsigned r; asm volatile("v_cvt_pk_bf16_f32 %0, %1, %2" : "=v"(r) : "v"(lo), "v"(hi)); return r;
}
template <typename TIn> struct Stage;
template <> struct Stage<bf16>  { using T = bf16x8;
  __device__ static __forceinline__ T ld8(const bf16* p) { return *reinterpret_cast<const bf16x8*>(p); }
  __device__ static __forceinline__ bf16x8 tobf(T x) { return x; } };
template <> struct Stage<float> { using T = f32x8;
  __device__ static __forceinline__ T ld8(const float* p) { return *reinterpret_cast<const f32x8*>(p); }
  __device__ static __forceinline__ bf16x8 tobf(T x) {
    u32x4 w = {cvtpk(x[0], x[1]), cvtpk(x[2], x[3]), cvtpk(x[4], x[5]), cvtpk(x[6], x[7])}; return *reinterpret_cast<bf16x8*>(&w); } };

__device__ __forceinline__ void partialSM(f32x16& p0, f32x16& p1, float& m_reg, float& mn, float& alpha) {
  constexpr float C = SCALE * 1.4426950408889634f;
  float pmax = p0[0]; for (int r = 1; r < 16; ++r) pmax = fmaxf(pmax, p0[r]); for (int r = 0; r < 16; ++r) pmax = fmaxf(pmax, p1[r]);
  { auto rr = __builtin_amdgcn_permlane32_swap(__float_as_uint(pmax), __float_as_uint(pmax), false, false);
    pmax = fmaxf(__uint_as_float(rr[0]), __uint_as_float(rr[1])); }
  if (__builtin_expect(__all(pmax - m_reg <= THR / SCALE), 1)) { mn = m_reg; alpha = 1.f; }
  else { mn = fmaxf(m_reg, pmax); alpha = __builtin_amdgcn_exp2f((m_reg - mn) * C); m_reg = mn; }
  float mnC = -mn * C;
  for (int r = 0; r < 16; ++r) p0[r] = fmaf(p0[r], C, mnC); for (int r = 0; r < 16; ++r) p1[r] = fmaf(p1[r], C, mnC);
  for (int r = 0; r < 16; ++r) p0[r] = __builtin_amdgcn_exp2f(p0[r]);
}
__device__ __forceinline__ void finishSM(f32x16& p0, f32x16& p1, float alpha, float& l_reg, bf16x8& pa0, bf16x8& pa1, bf16x8& pa2, bf16x8& pa3) {
  for (int r = 0; r < 16; ++r) p1[r] = __builtin_amdgcn_exp2f(p1[r]);
  float ps = 0; for (int r = 0; r < 16; ++r) ps += p0[r]; for (int r = 0; r < 16; ++r) ps += p1[r];
  { auto rr = __builtin_amdgcn_permlane32_swap(__float_as_uint(ps), __float_as_uint(ps), false, false);
    ps = __uint_as_float(rr[0]) + __uint_as_float(rr[1]); }
  l_reg = l_reg * alpha + ps;
#define PK4(P, BASE, OUT) do { unsigned a0 = cvtpk(P[BASE + 0], P[BASE + 1]), a1 = cvtpk(P[BASE + 2], P[BASE + 3]);   \
    unsigned b0 = cvtpk(P[BASE + 4], P[BASE + 5]), b1 = cvtpk(P[BASE + 6], P[BASE + 7]);                              \
    auto r0 = __builtin_amdgcn_permlane32_swap(a0, b0, false, false); auto r1 = __builtin_amdgcn_permlane32_swap(a1, b1, false, false); \
    u32x4 w = {r0[0], r1[0], r0[1], r1[1]}; OUT = *reinterpret_cast<bf16x8*>(&w); } while (0)
  PK4(p0, 0, pa0); PK4(p0, 8, pa1); PK4(p1, 0, pa2); PK4(p1, 8, pa3);
#undef PK4
}
__device__ __forceinline__ void qkt(f32x16& p0, f32x16& p1, const bf16* Ks, const bf16x8* qr, int r32, int hi) {
  p0 = f32x16{}; p1 = f32x16{};
  for (int d0 = 0; d0 < 8; ++d0) { int cb = (d0 * 16 + hi * 8) * 2;
    bf16x8 b0 = *reinterpret_cast<const bf16x8*>((const char*)Ks + KSWZ(r32, cb));
    bf16x8 b1 = *reinterpret_cast<const bf16x8*>((const char*)Ks + KSWZ(32 + r32, cb));
    p0 = __builtin_amdgcn_mfma_f32_32x32x16_bf16(b0, qr[d0], p0, 0, 0, 0);
    p1 = __builtin_amdgcn_mfma_f32_32x32x16_bf16(b1, qr[d0], p1, 0, 0, 0); }
}
__device__ __forceinline__ int v_st(int k, int c) { const int kk = (k & ~0xC) | ((k & 4) << 1) | ((k & 8) >> 1); return ((kk >> 3) * 4 + (c >> 5)) * 512 + ((kk & 7) * 32 + (c & 31)) * 2; }
__device__ __forceinline__ int v_rd_base(int lane) { return ((lane & 3) << 3) | (((lane >> 2) & 3) << 6) | (((lane >> 4) & 1) << 5) | (((lane >> 5) & 1) << 8); }
constexpr int v_rd_off(int d0, int ks, int half) { return d0 * 512 + ks * 4096 + half * 2048; }
template <int OFF> __device__ __forceinline__ s16x4 tr_read(int vb) {
  s16x4 r; asm volatile("ds_read_b64_tr_b16 %0, %1 offset:%2" : "=&v"(r) : "v"(vb), "i"(OFF) : "memory"); return r;
}
template <int D0> __device__ __forceinline__ void pv_one(f32x16& od, int vb, bf16x8 pa0, bf16x8 pa1, bf16x8 pa2, bf16x8 pa3) {
  const s16x4 l0 = tr_read<v_rd_off(D0, 0, 0)>(vb), h0 = tr_read<v_rd_off(D0, 0, 1)>(vb), l1 = tr_read<v_rd_off(D0, 1, 0)>(vb), h1 = tr_read<v_rd_off(D0, 1, 1)>(vb);
  const s16x4 l2 = tr_read<v_rd_off(D0, 2, 0)>(vb), h2 = tr_read<v_rd_off(D0, 2, 1)>(vb), l3 = tr_read<v_rd_off(D0, 3, 0)>(vb), h3 = tr_read<v_rd_off(D0, 3, 1)>(vb);
  asm volatile("s_waitcnt lgkmcnt(0)" ::: "memory"); SBAR();
#define PK(L, H) (bf16x8){L[0], L[1], L[2], L[3], H[0], H[1], H[2], H[3]}
  od = __builtin_amdgcn_mfma_f32_32x32x16_bf16(pa0, PK(l0, h0), od, 0, 0, 0);
  od = __builtin_amdgcn_mfma_f32_32x32x16_bf16(pa1, PK(l1, h1), od, 0, 0, 0);
  od = __builtin_amdgcn_mfma_f32_32x32x16_bf16(pa2, PK(l2, h2), od, 0, 0, 0);
  od = __builtin_amdgcn_mfma_f32_32x32x16_bf16(pa3, PK(l3, h3), od, 0, 0, 0);
#undef PK
}
__device__ __forceinline__ void pv_d0(f32x16* o, int vb, bf16x8 pa0, bf16x8 pa1, bf16x8 pa2, bf16x8 pa3) {
  pv_one<0>(o[0], vb, pa0, pa1, pa2, pa3); pv_one<1>(o[1], vb, pa0, pa1, pa2, pa3); pv_one<2>(o[2], vb, pa0, pa1, pa2, pa3); pv_one<3>(o[3], vb, pa0, pa1, pa2, pa3);
}

constexpr int QS_OFF = 69632;
template <typename TQ>
__device__ __forceinline__ void q_prep(TQ* Qb, const float* __restrict__ qg, int tq0) {
  using SQ = Stage<TQ>;
  const int tid = threadIdx.x, wid = tid >> 6, lane = tid & 63, r32 = lane & 31; int hi = lane >> 5;
  asm volatile("" : "+v"(hi));
  TQ* Qw = Qb + (long)(wid * QBLK + r32) * LDQ + hi * 8;
  bf16x8 raw[8]; float ss = 0.f;
#pragma unroll
  for (int d0 = 0; d0 < 8; ++d0) { raw[d0] = SQ::tobf(SQ::ld8(Qw + d0 * 16));
#pragma unroll
    for (int i = 0; i < 8; ++i) { const float v = __uint_as_float(((unsigned)(unsigned short)raw[d0][i]) << 16); ss += v * v; } }
  ss += __shfl_xor(ss, 32);
  const float rstd = rsqrtf(ss * (1.0f / 128.0f) + 1e-6f);
  const int tq = tq0 + wid * QBLK + r32;
#pragma unroll
  for (int ax = 0; ax < 2; ++ax) {
    const float fp = (float)(ax == 0 ? (tq >> 6) : (tq & 63));
#pragma unroll
    for (int dd = 0; dd < 2; ++dd) {
      const int da = ax * 4 + dd, db = da + 2; float oa[8], ob[8];
#pragma unroll
      for (int i = 0; i < 8; ++i) { const float freq = exp2f(-(float)(dd * 16 + hi * 8 + i) * (13.287712379549449f / 32.0f));
        float ar = fp * freq * 0.15915494309189535f; ar -= floorf(ar);
        const float sn = __builtin_amdgcn_sinf(ar), cs = __builtin_amdgcn_cosf(ar);
        const float x1 = __uint_as_float(((unsigned)(unsigned short)raw[da][i]) << 16) * rstd * qg[da * 16 + hi * 8 + i];
        const float x2 = __uint_as_float(((unsigned)(unsigned short)raw[db][i]) << 16) * rstd * qg[db * 16 + hi * 8 + i];
        oa[i] = x1 * cs - x2 * sn; ob[i] = x2 * cs + x1 * sn; }
      u32x4 wa = {cvtpk(oa[0], oa[1]), cvtpk(oa[2], oa[3]), cvtpk(oa[4], oa[5]), cvtpk(oa[6], oa[7])}, wb = {cvtpk(ob[0], ob[1]), cvtpk(ob[2], ob[3]), cvtpk(ob[4], ob[5]), cvtpk(ob[6], ob[7])};
      *reinterpret_cast<u32x4*>(Qw + da * 16) = wa; *reinterpret_cast<u32x4*>(Qw + db * 16) = wb;
      SBAR();
    }
  }
}
template <typename TQ>
__device__ __forceinline__ void attn_dense_body(const TQ* __restrict__ Qb, const bf16* __restrict__ Kh, const bf16* __restrict__ Vh,
                                                bf16* __restrict__ Ob, int seq, char* lds, const float* __restrict__ qg, int tq0) {
  using St = Stage<bf16>; using SQ = Stage<TQ>;
  const int tid = threadIdx.x, wid = tid >> 6, lane = tid & 63, r32 = lane & 31, hi = lane >> 5;
  bf16* V_lds = (bf16*)lds; bf16* K_lds = (bf16*)(lds + 2 * SHM_V);
  float* ws = (float*)(lds + 2 * SHM_V + 2 * SHM_K) + wid * 64; float* li_l = ws; float* al_l = ws + 32;
  float m_reg = -1e30f, l_reg = 0; f32x16 o[4] = {}; bf16x8 qr[8];
  const TQ* Qw = Qb + (long)(wid * QBLK + r32) * LDQ + hi * 8;
#pragma unroll
  for (int d0 = 0; d0 < 8; ++d0) qr[d0] = SQ::tobf(SQ::ld8(Qw + d0 * 16));
  const int sr = tid >> 4, sc = (tid & 15) * 8, vst0 = v_st(sr, sc), vst1 = v_st(32 + sr, sc);
  const int vb0 = (int)(uintptr_t)V_lds + v_rd_base(lane);
  struct { typename St::T vs0, vs1, ks0, ks1; } sr_[SDEPTH];
#define SLOAD(i, k0) do { sr_[i].vs0 = St::ld8(&Vh[(long)((k0) + sr) * LDK + sc]); sr_[i].vs1 = St::ld8(&Vh[(long)((k0) + 32 + sr) * LDK + sc]); \
    sr_[i].ks0 = St::ld8(&Kh[(long)((k0) + sr) * LDK + sc]); sr_[i].ks1 = St::ld8(&Kh[(long)((k0) + 32 + sr) * LDK + sc]); } while (0)
#define SWRITE(b, i) do { *(bf16x8*)((char*)V_lds + (b) * SHM_V + vst0) = St::tobf(sr_[i].vs0);          \
    *(bf16x8*)((char*)V_lds + (b) * SHM_V + vst1) = St::tobf(sr_[i].vs1); int kc = sc * 2;               \
    *(bf16x8*)((char*)K_lds + (b) * SHM_K + KSWZ(sr, kc)) = St::tobf(sr_[i].ks0);                       \
    *(bf16x8*)((char*)K_lds + (b) * SHM_K + KSWZ(32 + sr, kc)) = St::tobf(sr_[i].ks1); } while (0)
#define SWAIT() do { if constexpr (SDEPTH == 2) asm volatile("s_waitcnt vmcnt(4)" ::: "memory"); else asm volatile("s_waitcnt vmcnt(0)" ::: "memory"); } while (0)
#define RESC(a) do { if (__any((a) < 1.f)) { if (hi == 0) al_l[r32] = (a); asm volatile("s_waitcnt lgkmcnt(0)" ::: "memory"); \
    for (int d = 0; d < 4; ++d) for (int r = 0; r < 16; ++r) o[d][r] *= al_l[crow(r, hi)]; } } while (0)
  f32x16 pA0, pA1, pB0, pB1; float mnA, mnB, alA, alB; bf16x8 pa0, pa1, pa2, pa3; const int NT = seq / KVBLK;
  constexpr int SE = 0, SO = SDEPTH - 1;
  SLOAD(SE, 0); asm volatile("s_waitcnt vmcnt(0)" ::: "memory"); SWRITE(0, SE); __syncthreads();
  qkt(pA0, pA1, K_lds, qr, r32, hi); partialSM(pA0, pA1, m_reg, mnA, alA);
  SLOAD(SO, KVBLK); if constexpr (SDEPTH == 2) { if (2 < NT) SLOAD(SE, 2 * KVBLK); }
  SWAIT(); SWRITE(1, SO); __syncthreads();
  for (int j = 1; j + 1 < NT; j += 2) {
    SBAR(); qkt(pB0, pB1, (bf16*)((char*)K_lds + SHM_K), qr, r32, hi);
    finishSM(pA0, pA1, alA, l_reg, pa0, pa1, pa2, pa3); SBAR();
    SLOAD(SO, (j + SDEPTH) * KVBLK); SBAR();
    pv_d0(o, vb0, pa0, pa1, pa2, pa3); partialSM(pB0, pB1, m_reg, mnB, alB);
    __syncthreads(); SWAIT(); SWRITE(0, SE);
    RESC(alB); __syncthreads();
    SBAR(); qkt(pA0, pA1, K_lds, qr, r32, hi);
    finishSM(pB0, pB1, alB, l_reg, pa0, pa1, pa2, pa3); SBAR();
    if (SDEPTH == 1 || j + 3 < NT) SLOAD(SE, (j + 1 + SDEPTH) * KVBLK); SBAR();
    pv_d0(o, vb0 + (int)SHM_V, pa0, pa1, pa2, pa3); partialSM(pA0, pA1, m_reg, mnA, alA);
    __syncthreads(); SWAIT(); SWRITE(1, SO);
    RESC(alA); __syncthreads();
  }
  SBAR(); qkt(pB0, pB1, (bf16*)((char*)K_lds + SHM_K), qr, r32, hi);
  finishSM(pA0, pA1, alA, l_reg, pa0, pa1, pa2, pa3); SBAR();
  pv_d0(o, vb0, pa0, pa1, pa2, pa3); partialSM(pB0, pB1, m_reg, mnB, alB);
  __syncthreads(); RESC(alB);
  finishSM(pB0, pB1, alB, l_reg, pa0, pa1, pa2, pa3); SBAR();
  pv_d0(o, vb0 + (int)SHM_V, pa0, pa1, pa2, pa3);
  if (hi == 0) li_l[r32] = l_reg; asm volatile("s_waitcnt lgkmcnt(0)" ::: "memory");
  float rli[16];
#pragma unroll
  for (int r = 0; r < 16; ++r) rli[r] = __builtin_amdgcn_rcpf(li_l[crow(r, hi)]);
  bf16* Ow = Ob + (long)(wid * QBLK) * LDO;
#pragma unroll
  for (int r = 0; r < 16; ++r) { int orow = crow(r, hi);
    for (int d0 = 0; d0 < 4; ++d0) Ow[(long)orow * LDO + d0 * 32 + r32] = __float2bfloat16(o[d0][r] * rli[r]); }
#undef SLOAD
#undef SWRITE
#undef SWAIT
#undef RESC
}
#undef KSWZ
#undef SBAR
}
namespace cg = cooperative_groups;
#define LAS __attribute__((address_space(3)))
typedef unsigned short bf16_t;
typedef short bf16x8 __attribute__((ext_vector_type(8)));
typedef float f32x4 __attribute__((ext_vector_type(4)));
typedef unsigned u32x4 __attribute__((ext_vector_type(4)));
typedef unsigned u32x2 __attribute__((ext_vector_type(2)));

constexpr int DM = 2048, NB = 4, SEQ = 4096, CTX = 256, ML = NB * SEQ, MC = NB * CTX, MT = ML + MC, TKV = CTX + SEQ;
constexpr int AR_IN = 3584, DFF = 8192, NMOD = 6 * DM;
constexpr float EPS = 1e-6f;
constexpr size_t MiB = 1u << 20;
constexpr size_t WS_MOD = 0, WS_SUMA = 1 * MiB, WS_SUMH = 4 * MiB, WS_STATS = 7 * MiB, WS_WA = 8 * MiB, WS_WX = 8 * MiB + 512 * 1024, WS_WSP = 9 * MiB,
                 WS_WIN = 10 * MiB, WS_WOUT = 24 * MiB, WS_WFF1 = 32 * MiB, WS_WFF2 = 96 * MiB, WS_WGIN = 160 * MiB, WS_WGOUT = 176 * MiB,
                 WS_H = 184 * MiB, WS_KN = 252 * MiB, WS_VN = 261 * MiB, WS_A2 = 270 * MiB, WS_OL = 334 * MiB, WS_BIG = 398 * MiB, WS_CARRY = 654 * MiB, WS_PART = 656 * MiB, WS_CNT = 660 * MiB, WS_XL = 661 * MiB, WS_END = 725 * MiB;
constexpr int LDS_BYTES = 147456;
constexpr int NTHREADS = 512;

struct Params { const float* in[27]; float* out; unsigned char* ws; int ph_lo, ph_hi; };

__device__ __forceinline__ float bf2f(unsigned short h) { return __uint_as_float((unsigned)h << 16); }
__device__ __forceinline__ unsigned pk2(float lo, float hi) { unsigned r; asm volatile("v_cvt_pk_bf16_f32 %0, %1, %2" : "=v"(r) : "v"(lo), "v"(hi)); return r; }
__device__ __forceinline__ float wave_sum(float v) {
#pragma unroll
    for (int o = 1; o < 64; o <<= 1) v += __shfl_xor(v, o);
    return v;
}
__device__ __forceinline__ float sigm(float x) { return 1.0f / (1.0f + __expf(-x)); }
__device__ __forceinline__ float gelu_t(float x) { return pg8::gelu_tanh(x); }
#define LDS_WAIT() asm volatile("s_waitcnt lgkmcnt(0)" ::: "memory")

__device__ __forceinline__ void p0_mod(const float* c, const float* cctx, const float* wmod, const float* bmod, float* MOD, LAS unsigned char* lds, int bid, int G, int tid) {
    LAS float* S = (LAS float*)lds;
    LAS float* R = S + 5 * DM;
    if (bid >= 192) return;
    for (int i = tid; i < 5 * DM; i += NTHREADS) { const float v = i < 4 * DM ? c[i] : cctx[i - 4 * DM]; S[i] = v / (1.0f + __expf(-v)); }
    __syncthreads();
    for (int it = bid; it < 192; it += G) {
        const int layer = it / 96, n0 = (it % 96) * 128, cgp = tid & 31, ks = tid >> 5;
        const float* wp = wmod + (size_t)layer * DM * NMOD + (size_t)(ks * 128) * NMOD + n0 + cgp * 4;
        f32x4 acc[5];
#pragma unroll
        for (int r = 0; r < 5; ++r) acc[r] = (f32x4){0.f, 0.f, 0.f, 0.f};
#pragma unroll 8
        for (int k = 0; k < 128; ++k) { const f32x4 w = *(const f32x4*)(wp + (size_t)k * NMOD); const int kk = ks * 128 + k;
#pragma unroll
            for (int r = 0; r < 5; ++r) acc[r] += S[r * DM + kk] * w; }
#pragma unroll
        for (int r = 0; r < 5; ++r) *(LAS f32x4*)&R[(ks * 5 + r) * 128 + cgp * 4] = acc[r];
        __syncthreads();
        for (int o = tid; o < 640; o += NTHREADS) { const int r = o >> 7, n = o & 127; float s = 0.f;
#pragma unroll
            for (int k2 = 0; k2 < 16; ++k2) s += R[(k2 * 5 + r) * 128 + n];
            MOD[(size_t)(layer * 5 + r) * NMOD + n0 + n] = s + bmod[layer * NMOD + n0 + n]; }
        __syncthreads();
    }
}
__device__ __forceinline__ void p0_transpose_item(const float* W, int K, int N, bf16_t* WT, LAS float* scr, int item, int lane) {
    const int nblk = N / 32, kb = item / nblk, nb = item % nblk, k0 = 64 * kb, n0 = 32 * nb;
#pragma unroll 8
    for (int i = 0; i < 32; ++i) { const int kk = 2 * i + (lane >> 5); scr[kk * 33 + (lane & 31)] = W[(size_t)(k0 + kk) * N + n0 + (lane & 31)]; }
    LDS_WAIT(); asm volatile("" ::: "memory");
    const int c = lane & 7;
#pragma unroll
    for (int j = 0; j < 4; ++j) { const int n = (lane >> 3) + 8 * j; const LAS float* s = scr + (8 * c) * 33 + n;
        u32x4 o; o.x = pk2(s[0 * 33], s[1 * 33]); o.y = pk2(s[2 * 33], s[3 * 33]); o.z = pk2(s[4 * 33], s[5 * 33]); o.w = pk2(s[6 * 33], s[7 * 33]);
        *(u32x4*)(WT + (size_t)(n0 + n) * K + k0 + 8 * c) = o; }
    LDS_WAIT(); asm volatile("" ::: "memory");
}
__device__ __forceinline__ void p0_weights(const float* const* in, unsigned char* ws, LAS unsigned char* lds, int bid, int G, int tid) {
    const int wave = __builtin_amdgcn_readfirstlane(tid >> 6), lane = tid & 63;
    LAS float* scr = (LAS float*)(lds + wave * 8448);
    const int gw = bid * 8 + wave, NGW = G * 8;
    constexpr int I0 = 3584, I1 = 2048, I2 = 8192, I3 = 8192, I4 = 8192, I5 = 8192, I6 = 4096, I7 = 2048, I8 = 128, I9 = 128;
    constexpr int NIT = I0 + I1 + I2 + I3 + I4 + I5 + I6 + I7 + I8 + I9;
    int it0 = gw, it1 = NIT, step = NGW;
    if (G == 256) { it0 = (bid < 192 ? bid * 154 : 192 * 154 + (bid - 192) * 239); it1 = it0 + (bid < 192 ? 154 : 239); if (it1 > NIT) it1 = NIT; it0 += wave; step = 8; }
    for (int it = it0; it < it1; it += step) {
        int r = it;
        if (r < I2) { p0_transpose_item(in[7], DM, DFF, (bf16_t*)(ws + WS_WFF1), scr, r, lane); continue; } r -= I2;
        if (r < I4) { p0_transpose_item(in[8], DFF, DM, (bf16_t*)(ws + WS_WFF2), scr, r, lane); continue; } r -= I4;
        if (r < I3) { p0_transpose_item(in[7] + (size_t)DM * DFF, DM, DFF, (bf16_t*)(ws + WS_WFF1) + (size_t)DM * DFF, scr, r, lane); continue; } r -= I3;
        if (r < I5) { p0_transpose_item(in[8] + (size_t)DM * DFF, DFF, DM, (bf16_t*)(ws + WS_WFF2) + (size_t)DM * DFF, scr, r, lane); continue; } r -= I5;
        if (r < I0) { p0_transpose_item(in[9], DM, AR_IN, (bf16_t*)(ws + WS_WIN), scr, r, lane); continue; } r -= I0;
        if (r < I1) { p0_transpose_item(in[19], DM, DM, (bf16_t*)(ws + WS_WOUT), scr, r, lane); continue; } r -= I1;
        if (r < I6) { p0_transpose_item(in[20], DM, 4096, (bf16_t*)(ws + WS_WGIN), scr, r, lane); continue; } r -= I6;
        if (r < I7) { p0_transpose_item(in[26], DM, DM, (bf16_t*)(ws + WS_WGOUT), scr, r, lane); continue; } r -= I7;
        if (r < I8) { const int mi = r >> 3; p0_transpose_item(in[14] + (size_t)mi * 16384, 128, 128, (bf16_t*)(ws + WS_WA) + (size_t)mi * 16384, scr, r & 7, lane); continue; } r -= I8;
        { const int mi = r >> 3; p0_transpose_item(in[16] + (size_t)mi * 16384, 128, 128, (bf16_t*)(ws + WS_WX) + (size_t)mi * 16384, scr, r & 7, lane); }
    }
    const float* wsp = in[24]; bf16_t* WSP = (bf16_t*)(ws + WS_WSP);
    for (int i = (bid * NTHREADS + tid) * 4; i < 16 * 128 * 128; i += G * NTHREADS * 4) { const f32x4 v = *(const f32x4*)(wsp + i); u32x2 o; o.x = pk2(v[0], v[1]); o.y = pk2(v[2], v[3]); *(u32x2*)(WSP + i) = o; }
}

template <bool RES16, bool OUT16>
__device__ __forceinline__ void row_op(const void* res_, const bf16_t* o, const float* g_o, const float* gate, void* xl_out_,
                                       const float* g_n, const float* shift, const float* scale, bf16_t* h, int lane) {
    float x[32];
    if (RES16) { const bf16_t* res = (const bf16_t*)res_;
#pragma unroll
        for (int j = 0; j < 4; ++j) { const u32x4 w = *(const u32x4*)(res + j * 512 + lane * 8);
#pragma unroll
            for (int e = 0; e < 4; ++e) { x[j * 8 + 2 * e] = __uint_as_float(w[e] << 16); x[j * 8 + 2 * e + 1] = __uint_as_float(w[e] & 0xffff0000u); } }
    } else { const float* res = (const float*)res_;
#pragma unroll
    for (int j = 0; j < 4; ++j) { const float* rp = res + j * 512 + lane * 8; const f32x4 a = *(const f32x4*)rp, b = *(const f32x4*)(rp + 4);
        x[j * 8 + 0] = a[0]; x[j * 8 + 1] = a[1]; x[j * 8 + 2] = a[2]; x[j * 8 + 3] = a[3]; x[j * 8 + 4] = b[0]; x[j * 8 + 5] = b[1]; x[j * 8 + 6] = b[2]; x[j * 8 + 7] = b[3]; }
    }
    if (o) {
        float ov[32]; float ss = 0.f;
#pragma unroll
        for (int j = 0; j < 4; ++j) { const u32x4 w = *(const u32x4*)(o + j * 512 + lane * 8);
#pragma unroll
            for (int e = 0; e < 4; ++e) { ov[j * 8 + 2 * e] = __uint_as_float(w[e] << 16); ov[j * 8 + 2 * e + 1] = __uint_as_float(w[e] & 0xffff0000u); } }
#pragma unroll
        for (int i = 0; i < 32; ++i) ss += ov[i] * ov[i];
        const float rstd = rsqrtf(wave_sum(ss) * (1.0f / DM) + EPS);
#pragma unroll
        for (int j = 0; j < 4; ++j) { const int e0 = j * 512 + lane * 8;
            const f32x4 ga = *(const f32x4*)(g_o + e0), gb = *(const f32x4*)(g_o + e0 + 4), ta = *(const f32x4*)(gate + e0), tb = *(const f32x4*)(gate + e0 + 4);
#pragma unroll
            for (int e = 0; e < 4; ++e) { x[j * 8 + e] += ta[e] * (ov[j * 8 + e] * rstd * ga[e]); x[j * 8 + 4 + e] += tb[e] * (ov[j * 8 + 4 + e] * rstd * gb[e]); } }
    }
    if (xl_out_) {
        if (OUT16) { bf16_t* xl_out = (bf16_t*)xl_out_;
#pragma unroll
            for (int j = 0; j < 4; ++j) { u32x4 w; w.x = pk2(x[j * 8 + 0], x[j * 8 + 1]); w.y = pk2(x[j * 8 + 2], x[j * 8 + 3]); w.z = pk2(x[j * 8 + 4], x[j * 8 + 5]); w.w = pk2(x[j * 8 + 6], x[j * 8 + 7]);
                *(u32x4*)(xl_out + j * 512 + lane * 8) = w;
#pragma unroll
                for (int e = 0; e < 4; ++e) { x[j * 8 + 2 * e] = __uint_as_float(w[e] << 16); x[j * 8 + 2 * e + 1] = __uint_as_float(w[e] & 0xffff0000u); } }
        } else { float* xl_out = (float*)xl_out_;
#pragma unroll
        for (int j = 0; j < 4; ++j) { float* wp = xl_out + j * 512 + lane * 8;
            *(f32x4*)wp = (f32x4){x[j * 8 + 0], x[j * 8 + 1], x[j * 8 + 2], x[j * 8 + 3]}; *(f32x4*)(wp + 4) = (f32x4){x[j * 8 + 4], x[j * 8 + 5], x[j * 8 + 6], x[j * 8 + 7]}; }
        }
    }
    if (h) {
        float ss = 0.f;
#pragma unroll
        for (int i = 0; i < 32; ++i) ss += x[i] * x[i];
        const float rstd = rsqrtf(wave_sum(ss) * (1.0f / DM) + EPS);
#pragma unroll
        for (int j = 0; j < 4; ++j) { const int e0 = j * 512 + lane * 8; float hv[8];
            const f32x4 ga = *(const f32x4*)(g_n + e0), gb = *(const f32x4*)(g_n + e0 + 4), sa = *(const f32x4*)(scale + e0), sb = *(const f32x4*)(scale + e0 + 4),
                        ha = *(const f32x4*)(shift + e0), hb = *(const f32x4*)(shift + e0 + 4);
#pragma unroll
            for (int e = 0; e < 4; ++e) { hv[e] = x[j * 8 + e] * rstd * ga[e] * (1.0f + sa[e]) + ha[e]; hv[4 + e] = x[j * 8 + 4 + e] * rstd * gb[e] * (1.0f + sb[e]) + hb[e]; }
            u32x4 w; w.x = pk2(hv[0], hv[1]); w.y = pk2(hv[2], hv[3]); w.z = pk2(hv[4], hv[5]); w.w = pk2(hv[6], hv[7]);
            *(u32x4*)(h + e0) = w; }
    }
}

struct PanelOrder {
    int c, G;
    __device__ __forceinline__ bool next(int i, pg8::Unit& u) const { if (i >= 2 || G != 256) return false; const int xcd = c & 7, slot = c >> 3; u.pm = i * 32 + xcd * 4 + (slot >> 3); u.pn = slot & 7; return true; }
    __device__ __forceinline__ void a_ready(const pg8::Unit&) const {}
    __device__ __forceinline__ void done(const pg8::Unit&) const {}
};
template <bool RES16, bool OUT16> struct EpiPanel {
    static constexpr bool PERM = true, AFTER_DRAIN = false;
    bf16_t* O; unsigned* cnt;
    const void* res; const float* g_o; const float* gate; void* xl_out; const float* g_n; const float* shift; const float* scale; bf16_t* H;
    __device__ __forceinline__ void operator()(const pg8::f32x4 (&acc)[2][2][4][2], const pg8::Unit& u, int wr, int wc, int fr, int fq) const {
        const int row0 = u.pm * 256 + wr * 64 + fr, col0 = u.pn * 256 + wc * 32 + 8 * fq;
#pragma unroll
        for (int ai = 0; ai < 2; ++ai)
#pragma unroll
            for (int m = 0; m < 4; ++m) { bf16_t* rowp = O + (size_t)(row0 + ai * 128 + m * 16) * DM + col0;
#pragma unroll
                for (int bj = 0; bj < 2; ++bj) { const pg8::f32x4 v0 = acc[ai][bj][m][0], v1 = acc[ai][bj][m][1];
                    u32x4 w; w.x = pk2(v0[0], v0[1]); w.y = pk2(v0[2], v0[3]); w.z = pk2(v1[0], v1[1]); w.w = pk2(v1[2], v1[3]);
                    asm volatile("global_store_dwordx4 %0, %1, off sc1\n\ts_nop 2" :: "v"(rowp + bj * 128), "v"(w) : "memory"); } }
        asm volatile("s_waitcnt vmcnt(0)" ::: "memory");
        __builtin_amdgcn_s_barrier();
        if (threadIdx.x == 0) {
            unsigned* cw = cnt + 64 * u.pm;
            __hip_atomic_fetch_add(cw, 1u, __ATOMIC_RELAXED, __HIP_MEMORY_SCOPE_AGENT);
            unsigned spins = 0;
            while (__hip_atomic_load(cw, __ATOMIC_RELAXED, __HIP_MEMORY_SCOPE_AGENT) < 8u) { __builtin_amdgcn_s_sleep(2); if (++spins > (1u << 18)) break; }
            __builtin_amdgcn_fence(__ATOMIC_ACQUIRE, "agent");
            asm volatile("s_waitcnt vmcnt(0)" ::: "memory");
        }
        __builtin_amdgcn_s_barrier();
        asm volatile("" ::: "memory");
        const int wave = __builtin_amdgcn_readfirstlane(threadIdx.x >> 6), lane = threadIdx.x & 63;
#pragma unroll 1
        for (int k = 0; k < 4; ++k) { const int row = u.pm * 256 + u.pn * 32 + wave * 4 + k, b = row / SEQ;
            row_op<RES16, OUT16>((const char*)res + (size_t)row * DM * (RES16 ? 2 : 4), O + (size_t)row * DM, g_o, gate + (size_t)b * NMOD, (char*)xl_out + (size_t)row * DM * (OUT16 ? 2 : 4), g_n, shift + (size_t)b * NMOD, scale + (size_t)b * NMOD, H ? H + (size_t)row * DM : nullptr, lane); }
    }
};

__device__ __forceinline__ void k_post(bf16_t* PROJ, const float* kg, int gw, int NGW, int lane) {
    const int half = lane >> 5, l = lane & 31, head = l >> 4, c = l & 15;
    const int dm = c * 8, dother = dm ^ 32;
    float gown[8], goth[8];
#pragma unroll
    for (int i = 0; i < 8; ++i) { gown[i] = kg[dm + i]; goth[i] = kg[dother + i]; }
    const float sgn = (c & 4) ? 1.f : -1.f;
    for (int rp = gw; rp < MT / 2; rp += NGW) {
        const int row = rp * 2 + half, pos = row % TKV; const bool latent = pos >= CTX; const int t = pos - CTX;
        bf16_t* kp = PROJ + (size_t)row * AR_IN + 1024 + head * 128 + dm;
        const u32x4 raw = *(const u32x4*)kp;
        u32x4 oth;
#pragma unroll
        for (int e = 0; e < 4; ++e) oth[e] = (unsigned)__shfl_xor((int)raw[e], 4);
        float v[8], w[8]; float ss = 0.f;
#pragma unroll
        for (int e = 0; e < 4; ++e) { v[2 * e] = __uint_as_float(raw[e] << 16); v[2 * e + 1] = __uint_as_float(raw[e] & 0xffff0000u); w[2 * e] = __uint_as_float(oth[e] << 16); w[2 * e + 1] = __uint_as_float(oth[e] & 0xffff0000u); }
#pragma unroll
        for (int i = 0; i < 8; ++i) ss += v[i] * v[i];
        ss += __shfl_xor(ss, 1); ss += __shfl_xor(ss, 2); ss += __shfl_xor(ss, 4); ss += __shfl_xor(ss, 8);
        const float rstd = rsqrtf(ss * (1.0f / 128.0f) + EPS);
        const float apos = (float)((c < 8) ? (t >> 6) : (t & 63));
        float o[8];
#pragma unroll
        for (int i = 0; i < 8; ++i) { float cs = 1.f, sn = 0.f;
            if (latent) { const float freq = exp2f(-(float)(8 * (c & 3) + i) * (13.287712379549449f / 32.0f)); float ar = apos * freq * 0.15915494309189535f; ar -= floorf(ar);
                sn = __builtin_amdgcn_sinf(ar); cs = __builtin_amdgcn_cosf(ar); }
            o[i] = (v[i] * rstd * gown[i]) * cs + sgn * (w[i] * rstd * goth[i]) * sn; }
        u32x4 ov; ov.x = pk2(o[0], o[1]); ov.y = pk2(o[2], o[3]); ov.z = pk2(o[4], o[5]); ov.w = pk2(o[6], o[7]);
        *(u32x4*)kp = ov;
    }
}

constexpr int NCH = 34;
__device__ __forceinline__ float sigm_fast(float x) { return __builtin_amdgcn_rcpf(1.0f + __builtin_amdgcn_exp2f(-1.4426950408889634f * x)); }
template <int PASS>
__device__ __forceinline__ void rglru_pass(const float* const* in, unsigned char* ws, LAS unsigned char* lds, int bid, int G, int tid) {
    asm volatile("" : "+v"(tid));
    const bf16_t* PROJ = (const bf16_t*)(ws + WS_BIG);
    float* SUMA = (float*)(ws + WS_SUMA); float* SUMH = (float*)(ws + WS_SUMH); const float* CARRY = (const float*)(ws + WS_CARRY);
    const bf16_t* WA = (const bf16_t*)(ws + WS_WA); const bf16_t* WX = (const bf16_t*)(ws + WS_WX);
    bf16_t* A2 = (bf16_t*)(ws + WS_A2);
    u32x4* AB0 = (u32x4*)(ws + WS_H); u32x4* AB1 = (u32x4*)(ws + WS_OL);
    const float* conv_w = in[12]; const float* conv_b = in[13]; const float* ba = in[15]; const float* bx = in[17]; const float* lam = in[18];
    LAS bf16_t* XA = (LAS bf16_t*)lds;
    LAS bf16_t* GL = (LAS bf16_t*)(lds + 34816);
    const int lane = tid & 63, wave = __builtin_amdgcn_readfirstlane(tid >> 6), quad = lane >> 4, l15 = lane & 15, ch = 16 * wave + l15;
    LAS float* HF = (LAS float*)(lds + 69632) + wave * 2048 + lane;
    constexpr int NT = (PASS == 1 ? 136 : 128) * 8;
    int cur_nb = -1;
    bf16x8 wfa[2][4], wfx[2][4]; float bav[2], bxv[2], spv[2];
    const int cs8 = (tid & 15) * 8, g4 = tid >> 4;
    u32x4 xr[7], glr[4];
#define RG_DECODE(tt_, nb_, b_, j_, sb_, len_, gc_) do { nb_ = (tt_) & 7; int rest_ = (tt_) >> 3; \
        if (PASS == 1 && rest_ < 8) { b_ = rest_ >> 1; j_ = rest_ & 1; sb_ = b_ * TKV; len_ = CTX; gc_ = j_; } \
        else { if (PASS == 1) rest_ -= 8; b_ = rest_ >> 5; j_ = rest_ & 31; sb_ = b_ * TKV + CTX; len_ = SEQ; gc_ = 2 + j_; } } while (0)
#define RG_LOAD(tt_) do { int nb_, b_, j_, sb_, len_, gc_; RG_DECODE(tt_, nb_, b_, j_, sb_, len_, gc_); (void)gc_; const int cg_ = nb_ * 128 + cs8; \
        _Pragma("unroll") for (int r = 0; r < 7; ++r) { const int tq_ = j_ * 128 + 4 * g4 + r - 2; \
            xr[r] = (tq_ >= 0 && tq_ < len_) ? *(const u32x4*)(PROJ + (size_t)(sb_ + tq_) * AR_IN + 1536 + cg_) : (u32x4){0u, 0u, 0u, 0u}; } \
        } while (0)
    if (bid < NT) RG_LOAD(bid);
    for (int t = bid; t < NT; t += G) {
        int nb, b, j, seqbase, len, gc; RG_DECODE(t, nb, b, j, seqbase, len, gc); (void)len;
        const int t0 = j * 128, chg = nb * 128 + ch;
        if (nb != cur_nb) {
            cur_nb = nb;
#pragma unroll
            for (int d = 0; d < 2; ++d) {
                const bf16_t* wa = WA + ((size_t)(d * 8 + nb) * 128 + ch) * 128 + quad * 8; const bf16_t* wx = WX + ((size_t)(d * 8 + nb) * 128 + ch) * 128 + quad * 8;
#pragma unroll
                for (int ks = 0; ks < 4; ++ks) { wfa[d][ks] = *(const bf16x8*)(wa + 32 * ks); wfx[d][ks] = *(const bf16x8*)(wx + 32 * ks); }
                bav[d] = ba[d * 1024 + chg]; bxv[d] = bx[d * 1024 + chg]; spv[d] = 11.541560327111707f * log1pf(__expf(-lam[d * 1024 + chg]));
            }
        }
        if (PASS == 2) {
#pragma unroll
            for (int tk = 0; tk < 4; ++tk) glr[tk] = *(const u32x4*)(PROJ + (size_t)(seqbase + t0 + 4 * g4 + tk) * AR_IN + 2560 + nb * 128 + cs8);
        }
        float cf = 0.f, cb = 0.f;
        if (PASS == 2) { cf = CARRY[((size_t)(0 * NB + b) * 32 + j) * 1024 + chg]; cb = CARRY[((size_t)(1 * NB + b) * 32 + j) * 1024 + chg]; }
        __syncthreads();
        {
            const int cg = nb * 128 + cs8;
            f32x4 cw[4][2]; const f32x4 cb0 = *(const f32x4*)(conv_b + cg), cb1 = *(const f32x4*)(conv_b + cg + 4);
#pragma unroll
            for (int jt = 0; jt < 4; ++jt) { cw[jt][0] = *(const f32x4*)(conv_w + jt * 1024 + cg); cw[jt][1] = *(const f32x4*)(conv_w + jt * 1024 + cg + 4); }
#pragma unroll
            for (int tk = 0; tk < 4; ++tk) {
                f32x4 y0 = cb0, y1 = cb1;
#pragma unroll
                for (int jt = 0; jt < 4; ++jt) { const u32x4 w = xr[tk + jt];
                    y0[0] += cw[jt][0][0] * __uint_as_float(w[0] << 16); y0[1] += cw[jt][0][1] * __uint_as_float(w[0] & 0xffff0000u);
                    y0[2] += cw[jt][0][2] * __uint_as_float(w[1] << 16); y0[3] += cw[jt][0][3] * __uint_as_float(w[1] & 0xffff0000u);
                    y1[0] += cw[jt][1][0] * __uint_as_float(w[2] << 16); y1[1] += cw[jt][1][1] * __uint_as_float(w[2] & 0xffff0000u);
                    y1[2] += cw[jt][1][2] * __uint_as_float(w[3] << 16); y1[3] += cw[jt][1][3] * __uint_as_float(w[3] & 0xffff0000u); }
                u32x4 o; o.x = pk2(y0[0], y0[1]); o.y = pk2(y0[2], y0[3]); o.z = pk2(y1[0], y1[1]); o.w = pk2(y1[2], y1[3]);
                *(LAS u32x4*)(XA + (4 * g4 + tk) * 136 + cs8) = o;
            }
            if (PASS == 2) {
#pragma unroll
                for (int tk = 0; tk < 4; ++tk) *(LAS u32x4*)(GL + (4 * g4 + tk) * 136 + cs8) = glr[tk];
            }
        }
        __syncthreads();
        if (t + G < NT) RG_LOAD(t + G);
        {
            float S = cf, AT = 1.f;
#pragma unroll 2
            for (int st = 0; st < 8; ++st) {
                f32x4 ca = {0.f, 0.f, 0.f, 0.f}, cx = {0.f, 0.f, 0.f, 0.f};
#pragma unroll
                for (int ks = 0; ks < 4; ++ks) { const bf16x8 af = *(const LAS bf16x8*)(XA + (16 * st + l15) * 136 + 32 * ks + quad * 8);
                    ca = __builtin_amdgcn_mfma_f32_16x16x32_bf16(af, wfa[0][ks], ca, 0, 0, 0); cx = __builtin_amdgcn_mfma_f32_16x16x32_bf16(af, wfx[0][ks], cx, 0, 0, 0); }
                float a[4], bq[4];
                u32x4 abw;
#pragma unroll
                for (int jj = 0; jj < 4; ++jj) { const float r = sigm_fast(ca[jj] + bav[0]), ig = sigm_fast(cx[jj] + bxv[0]);
                    const unsigned wl = pk2(-r * spv[0], 0.f) & 0xffffu; a[jj] = __builtin_amdgcn_exp2f(__uint_as_float(wl << 16));
                    const float xv = bf2f(XA[(16 * st + 4 * quad + jj) * 136 + ch]); const unsigned wb = pk2(__builtin_amdgcn_sqrtf(fmaxf(1.0f - a[jj] * a[jj], 0.f)) * (ig * xv), 0.f) << 16;
                    bq[jj] = __uint_as_float(wb); abw[jj] = wl | wb; }
                if (gc >= 2) AB0[((((size_t)(b * 32 + j) * 8 + nb) * 8 + wave) * 8 + st) * 64 + lane] = abw;
                float A = a[0], H = bq[0];
#pragma unroll
                for (int jj = 1; jj < 4; ++jj) { H = a[jj] * H + bq[jj]; A *= a[jj]; }
                { const float Ap = __shfl_up(A, 16), Hp = __shfl_up(H, 16); if (quad >= 1) { H = A * Hp + H; A = Ap * A; } }
                { const float Ap = __shfl_up(A, 32), Hp = __shfl_up(H, 32); if (quad >= 2) { H = A * Hp + H; A = Ap * A; } }
                float Ae = __shfl_up(A, 16), He = __shfl_up(H, 16); if (quad == 0) { Ae = 1.f; He = 0.f; }
                const float Atot = __shfl(A, 48 + l15), Htot = __shfl(H, 48 + l15);
                float s = Ae * S + He;
#pragma unroll
                for (int jj = 0; jj < 4; ++jj) { s = a[jj] * s + bq[jj]; if (PASS == 2) HF[(st * 4 + jj) * 64] = s; }
                S = Atot * S + Htot; AT *= Atot;
            }
            if (PASS == 1 && quad == 0) { const size_t o = ((size_t)(0 * NB + b) * NCH + gc) * 1024 + chg; SUMA[o] = AT; SUMH[o] = S; }
        }
        {
            float S = cb, AT = 1.f;
#pragma unroll 2
            for (int st = 7; st >= 0; --st) {
                f32x4 ca = {0.f, 0.f, 0.f, 0.f}, cx = {0.f, 0.f, 0.f, 0.f};
#pragma unroll
                for (int ks = 0; ks < 4; ++ks) { const bf16x8 af = *(const LAS bf16x8*)(XA + (16 * st + l15) * 136 + 32 * ks + quad * 8);
                    ca = __builtin_amdgcn_mfma_f32_16x16x32_bf16(af, wfa[1][ks], ca, 0, 0, 0); cx = __builtin_amdgcn_mfma_f32_16x16x32_bf16(af, wfx[1][ks], cx, 0, 0, 0); }
                float a[4], bq[4];
                u32x4 abw;
#pragma unroll
                for (int jj = 0; jj < 4; ++jj) { const float r = sigm_fast(ca[jj] + bav[1]), ig = sigm_fast(cx[jj] + bxv[1]);
                    const unsigned wl = pk2(-r * spv[1], 0.f) & 0xffffu; a[jj] = __builtin_amdgcn_exp2f(__uint_as_float(wl << 16));
                    const float xv = bf2f(XA[(16 * st + 4 * quad + jj) * 136 + ch]); const unsigned wb = pk2(__builtin_amdgcn_sqrtf(fmaxf(1.0f - a[jj] * a[jj], 0.f)) * (ig * xv), 0.f) << 16;
                    bq[jj] = __uint_as_float(wb); abw[jj] = wl | wb; }
                if (gc >= 2) AB1[((((size_t)(b * 32 + j) * 8 + nb) * 8 + wave) * 8 + st) * 64 + lane] = abw;
                float A = a[3], H = bq[3];
#pragma unroll
                for (int jj = 2; jj >= 0; --jj) { H = a[jj] * H + bq[jj]; A *= a[jj]; }
                { const float Ap = __shfl_down(A, 16), Hp = __shfl_down(H, 16); if (quad <= 2) { H = A * Hp + H; A = Ap * A; } }
                { const float Ap = __shfl_down(A, 32), Hp = __shfl_down(H, 32); if (quad <= 1) { H = A * Hp + H; A = Ap * A; } }
                float Ae = __shfl_down(A, 16), He = __shfl_down(H, 16); if (quad == 3) { Ae = 1.f; He = 0.f; }
                const float Atot = __shfl(A, l15), Htot = __shfl(H, l15);
                float s = Ae * S + He;
#pragma unroll
                for (int jj = 3; jj >= 0; --jj) { s = a[jj] * s + bq[jj];
                    if (PASS == 2) { LAS bf16_t* gp = GL + (16 * st + 4 * quad + jj) * 136 + ch; const float o = (HF[(st * 4 + jj) * 64] + s) * gelu_t(bf2f(*gp));
                        *gp = (bf16_t)(pk2(o, 0.f) & 0xffffu); } }
                S = Atot * S + Htot; AT *= Atot;
            }
            if (PASS == 1 && quad == 0) { const size_t o = ((size_t)(1 * NB + b) * NCH + gc) * 1024 + chg; SUMA[o] = AT; SUMH[o] = S; }
        }
        if (PASS == 2) {
            __syncthreads();
#pragma unroll
            for (int tk = 0; tk < 4; ++tk) *(u32x4*)(A2 + (size_t)(b * SEQ + t0 + 4 * g4 + tk) * DM + 1024 + nb * 128 + cs8) = *(const LAS u32x4*)(GL + (4 * g4 + tk) * 136 + cs8);
        }
    }
    __syncthreads();
#undef RG_LOAD
#undef RG_DECODE
}
__device__ __forceinline__ void rglru_pass2(unsigned char* ws, LAS unsigned char* lds, int bid, int G, int tid) {
    asm volatile("" : "+v"(tid));
    const bf16_t* PROJ = (const bf16_t*)(ws + WS_BIG); const float* CARRY = (const float*)(ws + WS_CARRY); bf16_t* A2 = (bf16_t*)(ws + WS_A2);
    const u32x4* AB0 = (const u32x4*)(ws + WS_H); const u32x4* AB1 = (const u32x4*)(ws + WS_OL);
    LAS bf16_t* GL = (LAS bf16_t*)(lds + 34816);
    const int lane = tid & 63, wave = __builtin_amdgcn_readfirstlane(tid >> 6), quad = lane >> 4, l15 = lane & 15, ch = 16 * wave + l15;
    LAS float* HF = (LAS float*)(lds + 69632) + wave * 2048 + lane;
    const int cs8 = (tid & 15) * 8, g4 = tid >> 4;
    constexpr int NT = 128 * 8;
    u32x4 abf[8], abb[8];
#define AB_BASE(tt_) (((((size_t)((tt_) >> 3) * 8 + ((tt_) & 7)) * 8 + wave) * 8) * 64 + lane)
    if (bid < NT) {
#pragma unroll
        for (int st = 0; st < 8; ++st) { abf[st] = AB0[AB_BASE(bid) + st * 64]; abb[st] = AB1[AB_BASE(bid) + st * 64]; }
    }
    u32x4 glr[4]; float cfn = 0.f, cbn = 0.f;
#define P2_LOAD(tt_) do { const int nb_ = (tt_) & 7, rest_ = (tt_) >> 3, b_ = rest_ >> 5, j_ = rest_ & 31; \
        _Pragma("unroll") for (int tk = 0; tk < 4; ++tk) glr[tk] = *(const u32x4*)(PROJ + (size_t)(b_ * TKV + CTX + j_ * 128 + 4 * g4 + tk) * AR_IN + 2560 + nb_ * 128 + cs8); \
        cfn = CARRY[((size_t)(0 * NB + b_) * 32 + j_) * 1024 + nb_ * 128 + ch]; cbn = CARRY[((size_t)(1 * NB + b_) * 32 + j_) * 1024 + nb_ * 128 + ch]; } while (0)
    if (bid < NT) P2_LOAD(bid);
    for (int t = bid; t < NT; t += G) {
        const int nb = t & 7, rest = t >> 3, b = rest >> 5, j = rest & 31, t0 = j * 128;
        const float cf = cfn, cb = cbn;
        __syncthreads();
#pragma unroll
        for (int tk = 0; tk < 4; ++tk) *(LAS u32x4*)(GL + (4 * g4 + tk) * 136 + cs8) = glr[tk];
        __syncthreads();
        if (t + G < NT) P2_LOAD(t + G);
        {
            float S = cf;
#pragma unroll
            for (int st = 0; st < 8; ++st) {
                float a[4], bq[4];
#pragma unroll
                for (int jj = 0; jj < 4; ++jj) { a[jj] = __builtin_amdgcn_exp2f(__uint_as_float(abf[st][jj] << 16)); bq[jj] = __uint_as_float(abf[st][jj] & 0xffff0000u); }
                float A = a[0], H = bq[0];
#pragma unroll
                for (int jj = 1; jj < 4; ++jj) { H = a[jj] * H + bq[jj]; A *= a[jj]; }
                { const float Ap = __shfl_up(A, 16), Hp = __shfl_up(H, 16); if (quad >= 1) { H = A * Hp + H; A = Ap * A; } }
                { const float Ap = __shfl_up(A, 32), Hp = __shfl_up(H, 32); if (quad >= 2) { H = A * Hp + H; A = Ap * A; } }
                float Ae = __shfl_up(A, 16), He = __shfl_up(H, 16); if (quad == 0) { Ae = 1.f; He = 0.f; }
                const float Atot = __shfl(A, 48 + l15), Htot = __shfl(H, 48 + l15);
                float s = Ae * S + He;
#pragma unroll
                for (int jj = 0; jj < 4; ++jj) { s = a[jj] * s + bq[jj]; HF[(st * 4 + jj) * 64] = s; }
                S = Atot * S + Htot;
            }
        }
        if (t + G < NT) {
#pragma unroll
            for (int st = 0; st < 8; ++st) abf[st] = AB0[AB_BASE(t + G) + st * 64];
        }
        {
            float S = cb;
#pragma unroll
            for (int st = 7; st >= 0; --st) {
                float a[4], bq[4];
#pragma unroll
                for (int jj = 0; jj < 4; ++jj) { a[jj] = __builtin_amdgcn_exp2f(__uint_as_float(abb[st][jj] << 16)); bq[jj] = __uint_as_float(abb[st][jj] & 0xffff0000u); }
                float A = a[3], H = bq[3];
#pragma unroll
                for (int jj = 2; jj >= 0; --jj) { H = a[jj] * H + bq[jj]; A *= a[jj]; }
                { const float Ap = __shfl_down(A, 16), Hp = __shfl_down(H, 16); if (quad <= 2) { H = A * Hp + H; A = Ap * A; } }
                { const float Ap = __shfl_down(A, 32), Hp = __shfl_down(H, 32); if (quad <= 1) { H = A * Hp + H; A = Ap * A; } }
                float Ae = __shfl_down(A, 16), He = __shfl_down(H, 16); if (quad == 3) { Ae = 1.f; He = 0.f; }
                const float Atot = __shfl(A, l15), Htot = __shfl(H, l15);
                float s = Ae * S + He;
#pragma unroll
                for (int jj = 3; jj >= 0; --jj) { s = a[jj] * s + bq[jj];
                    LAS bf16_t* gp = GL + (16 * st + 4 * quad + jj) * 136 + ch; const float o = (HF[(st * 4 + jj) * 64] + s) * gelu_t(bf2f(*gp));
                    *gp = (bf16_t)(pk2(o, 0.f) & 0xffffu); }
                S = Atot * S + Htot;
            }
        }
        if (t + G < NT) {
#pragma unroll
            for (int st = 0; st < 8; ++st) abb[st] = AB1[AB_BASE(t + G) + st * 64];
        }
        __syncthreads();
#pragma unroll
        for (int tk = 0; tk < 4; ++tk) *(u32x4*)(A2 + (size_t)(b * SEQ + t0 + 4 * g4 + tk) * DM + 1024 + nb * 128 + cs8) = *(const LAS u32x4*)(GL + (4 * g4 + tk) * 136 + cs8);
    }
    __syncthreads();
#undef AB_BASE
#undef P2_LOAD
}
__device__ __forceinline__ void rglru_carry(unsigned char* ws, int gtid) {
    if (gtid >= 2 * NB * 1024) return;
    const int ch = gtid & 1023, b = (gtid >> 10) & 3, dir = gtid >> 12;
    const float* pa = (const float*)(ws + WS_SUMA) + (size_t)(dir * NB + b) * NCH * 1024 + ch; const float* ph = (const float*)(ws + WS_SUMH) + (size_t)(dir * NB + b) * NCH * 1024 + ch;
    float* cp = (float*)(ws + WS_CARRY) + (size_t)(dir * NB + b) * 32 * 1024 + ch;
    float A[NCH], Hh[NCH];
#pragma unroll
    for (int g = 0; g < NCH; ++g) { A[g] = pa[(size_t)g * 1024]; Hh[g] = ph[(size_t)g * 1024]; }
    float s = 0.f;
    if (dir == 0) {
#pragma unroll
        for (int g = 0; g < NCH; ++g) { if (g >= 2) cp[(size_t)(g - 2) * 1024] = s; s = A[g] * s + Hh[g]; }
    } else {
#pragma unroll
        for (int g = 1; g >= 0; --g) s = A[g] * s + Hh[g];
#pragma unroll
        for (int g = NCH - 1; g >= 2; --g) { cp[(size_t)(g - 2) * 1024] = s; s = A[g] * s + Hh[g]; }
    }
}

__device__ __forceinline__ void gm_stats_row(const bf16_t* Z, float* STATS, int row, int lane) {
    const bf16_t* vp = Z + (size_t)row * 4096 + 2048; float v[32]; float s = 0.f;
#pragma unroll
    for (int j = 0; j < 4; ++j) { const u32x4 w = *(const u32x4*)(vp + j * 512 + lane * 8);
#pragma unroll
        for (int e = 0; e < 4; ++e) { v[j * 8 + 2 * e] = __uint_as_float(w[e] << 16); v[j * 8 + 2 * e + 1] = __uint_as_float(w[e] & 0xffff0000u); } }
#pragma unroll
    for (int i = 0; i < 32; ++i) s += v[i];
    const float mean = wave_sum(s) * (1.0f / 2048.0f); float q = 0.f;
#pragma unroll
    for (int i = 0; i < 32; ++i) { const float d = v[i] - mean; q += d * d; }
    const float rstd = rsqrtf(wave_sum(q) * (1.0f / 2048.0f) + EPS);
    if (lane == 0) { STATS[2 * row] = mean; STATS[2 * row + 1] = rstd; }
}
__device__ __forceinline__ void gm_spatial_pass(const float* const* in, unsigned char* ws, LAS unsigned char* lds, int bid, int G, int tid) {
    const bf16_t* Z = (const bf16_t*)(ws + WS_BIG); const float* PART = (const float*)(ws + WS_PART); const bf16_t* WSP = (const bf16_t*)(ws + WS_WSP);
    bf16_t* A2 = (bf16_t*)(ws + WS_A2);
    const float* vg = in[22]; const float* vb = in[23]; const float* bsp = in[25];
    LAS bf16_t* VT = (LAS bf16_t*)lds;
    const int lane = tid & 63, wave = __builtin_amdgcn_readfirstlane(tid >> 6), quad = lane >> 4, l15 = lane & 15;
    const int q = tid >> 2, seg = (tid & 3) * 32;
    constexpr int NT = 128 * 16;
    u32x4 vr[4], vrA[4], vrB[4]; f32x4 pr[4], prA[4], prB[4];
    const int ptok = 16 * wave + l15; int cur_g = -1; bf16x8 bw[4]; float bias = 0.f; f32x4 vgr[8], vbr[8]; u32x2 uwv[8];
#define GM_LOAD(tt_) do { const int g_ = (tt_) & 15; const size_t row_ = (size_t)((tt_) >> 4) * 128 + q; const bf16_t* vp_ = Z + row_ * 4096 + 2048 + g_ * 128 + seg; const float* pp_ = PART + row_ * 64 + (tid & 3) * 16; \
        _Pragma("unroll") for (int k = 0; k < 4; ++k) { vrB[k] = *(const u32x4*)(vp_ + 8 * k); prB[k] = *(const f32x4*)(pp_ + 4 * k); } \
        const bf16_t* up_ = Z + ((size_t)((tt_) >> 4) * 128 + ptok) * 4096 + g_ * 128; \
        _Pragma("unroll") for (int dt = 0; dt < 8; ++dt) uwB[dt] = *(const u32x2*)(up_ + 16 * dt + quad * 4); } while (0)
    u32x2 uwA[8], uwB[8];
#define GM_ROT() do { _Pragma("unroll") for (int k = 0; k < 4; ++k) { vrA[k] = vrB[k]; prA[k] = prB[k]; } _Pragma("unroll") for (int dt = 0; dt < 8; ++dt) uwA[dt] = uwB[dt]; } while (0)
    if (bid < NT) { GM_LOAD(bid); GM_ROT(); }
    if (bid + G < NT) GM_LOAD(bid + G);
    for (int t = bid; t < NT; t += G) {
        const int g = t & 15; const size_t r0 = (size_t)(t >> 4) * 128;
#pragma unroll
        for (int k = 0; k < 4; ++k) { vr[k] = vrA[k]; pr[k] = prA[k]; }
        if (g != cur_g) {
#pragma unroll
            for (int k = 0; k < 8; ++k) { vgr[k] = *(const f32x4*)(vg + g * 128 + seg + 4 * k); vbr[k] = *(const f32x4*)(vb + g * 128 + seg + 4 * k); }
        }
#pragma unroll
        for (int dt = 0; dt < 8; ++dt) uwv[dt] = uwA[dt];
        GM_ROT();
        {
            float s1 = 0.f, s2 = 0.f;
#pragma unroll
            for (int k = 0; k < 4; ++k) { s1 += pr[k][0] + pr[k][2]; s2 += pr[k][1] + pr[k][3]; }
            s1 += __shfl_xor(s1, 1); s1 += __shfl_xor(s1, 2); s2 += __shfl_xor(s2, 1); s2 += __shfl_xor(s2, 2);
            const float mean = s1 * (1.0f / 2048.0f), rstd = rsqrtf(fmaxf(s2 * (1.0f / 2048.0f) - mean * mean, 0.f) + EPS);
#pragma unroll
            for (int k = 0; k < 4; ++k) { const u32x4 w = vr[k];
#pragma unroll
                for (int e = 0; e < 4; ++e) { const int d = seg + 8 * k + 2 * e;
                    const float a = (__uint_as_float(w[e] << 16) - mean) * rstd * vgr[2 * k + (e >> 1)][(2 * e) & 3] + vbr[2 * k + (e >> 1)][(2 * e) & 3], bq = (__uint_as_float(w[e] & 0xffff0000u) - mean) * rstd * vgr[2 * k + (e >> 1)][((2 * e) & 3) + 1] + vbr[2 * k + (e >> 1)][((2 * e) & 3) + 1];
                    const unsigned pk = pk2(a, bq); VT[d * 136 + q] = (bf16_t)(pk & 0xffffu); VT[(d + 1) * 136 + q] = (bf16_t)(pk >> 16); } }
        }
        __syncthreads();
        if (t + 2 * G < NT) GM_LOAD(t + 2 * G);
        if (g != cur_g) { cur_g = g;
#pragma unroll
            for (int ks = 0; ks < 4; ++ks) bw[ks] = *(const bf16x8*)(WSP + ((size_t)g * 128 + ptok) * 128 + 32 * ks + quad * 8);
            bias = bsp[g * 128 + ptok]; }
        bf16_t* op = A2 + (r0 + ptok) * DM + g * 128;
#pragma unroll
        for (int dt = 0; dt < 8; ++dt) {
            f32x4 acc = {0.f, 0.f, 0.f, 0.f};
#pragma unroll
            for (int ks = 0; ks < 4; ++ks) { const bf16x8 av = *(const LAS bf16x8*)(VT + (16 * dt + l15) * 136 + 32 * ks + quad * 8); acc = __builtin_amdgcn_mfma_f32_16x16x32_bf16(av, bw[ks], acc, 0, 0, 0); }
            const int d0 = 16 * dt + quad * 4; const u32x2 uw = uwv[dt];
            const float u0 = __uint_as_float(uw.x << 16), u1 = __uint_as_float(uw.x & 0xffff0000u), u2 = __uint_as_float(uw.y << 16), u3 = __uint_as_float(uw.y & 0xffff0000u);
            u32x2 o; o.x = pk2(u0 * (acc[0] + bias), u1 * (acc[1] + bias)); o.y = pk2(u2 * (acc[2] + bias), u3 * (acc[3] + bias));
            *(u32x2*)(op + d0) = o;
        }
        __syncthreads();
    }
#undef GM_LOAD
#undef GM_ROT
}

#define XB_TMO      128
#define XB_XCNT(j)  (256  + 64 * (j))
#define XB_XSUB(j)  (1280 + 64 * (j))
#define XB_XGEN(j)  (2304 + 64 * (j))
#define XB_TOP      3328
#define XB_TOPGEN   3392
#define XCD_BAR_WORDS 3456
#define XB_SPIN_CAP (1u << 18)

__device__ __forceinline__ unsigned xb_ld(unsigned* p)              { return __hip_atomic_load(p, __ATOMIC_RELAXED, __HIP_MEMORY_SCOPE_AGENT); }
__device__ __forceinline__ unsigned xb_add(unsigned* p, unsigned v) { return __hip_atomic_fetch_add(p, v, __ATOMIC_RELAXED, __HIP_MEMORY_SCOPE_AGENT); }
__device__ __forceinline__ unsigned xb_xcc_id() { return (unsigned)__builtin_amdgcn_s_getreg((3 << 11) | 20) & 0xFu; }
#define XB_SPIN(cond, bar) do { unsigned _sp = 0; while (cond) { __builtin_amdgcn_s_sleep(1); \
    if ((++_sp & 255u) == 0u) { if (xb_ld(&(bar)[XB_TMO])) break; if (_sp > XB_SPIN_CAP) { atomicAdd(&(bar)[XB_TMO], 1u); break; } } } } while (0)

struct XcdBarrier {
    unsigned* bar; unsigned x;
    volatile LAS unsigned* st;
};

__device__ __forceinline__ XcdBarrier xcd_barrier_post(unsigned* bar, volatile LAS unsigned* st) {
    XcdBarrier b; b.bar = bar; b.x = xb_xcc_id(); b.st = st;
    if (threadIdx.x == 0) (void)xb_add(&bar[XB_XCNT(b.x)], 1u);
    return b;
}
__device__ __forceinline__ void xcd_barrier_complete(unsigned* bar, unsigned x, unsigned& nloc, unsigned& nx) {
    const unsigned G = gridDim.x * gridDim.y * gridDim.z;
    unsigned sum, cnt, mine, sp = 0u;
    for (;;) {
        sum = 0u; cnt = 0u; mine = 0u;
#pragma unroll
        for (unsigned j = 0; j < 16; ++j) { const unsigned c = xb_ld(&bar[XB_XCNT(j)]); sum += c; cnt += (c > 0u) ? 1u : 0u; mine = (j == x) ? c : mine; }
        if (sum == G) break;
        __builtin_amdgcn_s_sleep(1);
        if ((++sp & 255u) == 0u) { if (xb_ld(&bar[XB_TMO])) break; if (sp > XB_SPIN_CAP) { atomicAdd(&bar[XB_TMO], 1u); break; } }
    }
    nloc = mine > 0u ? mine : 1u; nx = cnt > 0u ? cnt : 1u;
}

__device__ __forceinline__ void xcd_barrier(const XcdBarrier& b) {
    asm volatile("s_waitcnt vmcnt(0)" ::: "memory");
    __syncthreads();
    if (threadIdx.x == 0) {
        unsigned* bar = b.bar;
        __builtin_amdgcn_s_waitcnt(0);
        unsigned nloc = b.st[0], nx = b.st[1];
        if (nloc == 0u) { xcd_barrier_complete(bar, b.x, nloc, nx); b.st[0] = nloc; b.st[1] = nx; }
        const unsigned old = xb_add(&bar[XB_XSUB(b.x)], 1u);
        const unsigned gen = old / nloc;
        if (old + 1u == (gen + 1u) * nloc) {
            __builtin_amdgcn_fence(__ATOMIC_RELEASE, "agent");
            asm volatile("s_waitcnt vmcnt(0)" ::: "memory");
            const unsigned og = xb_add(&bar[XB_TOP], 1u);
            const unsigned tg = og / nx;
            if (og + 1u == (tg + 1u) * nx) xb_add(&bar[XB_TOPGEN], 1u);
            else XB_SPIN(xb_ld(&bar[XB_TOPGEN]) == tg, bar);
            __builtin_amdgcn_fence(__ATOMIC_ACQUIRE, "agent");
            xb_add(&bar[XB_XGEN(b.x)], 1u);
            asm volatile("s_waitcnt vmcnt(0)" ::: "memory");
        } else {
            XB_SPIN(xb_ld(&bar[XB_XGEN(b.x)]) == gen, bar);
            __builtin_amdgcn_fence(__ATOMIC_ACQUIRE, "agent");
            asm volatile("s_waitcnt vmcnt(0)" ::: "memory");
        }
    }
    __syncthreads();
}

__global__ void __launch_bounds__(NTHREADS) mega(Params P) {
    extern __shared__ __attribute__((aligned(16))) unsigned char lds_raw[];
    cg::grid_group grid = cg::this_grid();
    LAS unsigned char* lds = (LAS unsigned char*)lds_raw;
    const int tid = threadIdx.x, lane = tid & 63, wave = __builtin_amdgcn_readfirstlane(tid >> 6), bid = blockIdx.x, G = gridDim.x;
    const int gw = bid * 8 + wave, NGW = G * 8;
    unsigned char* ws = P.ws;
    volatile LAS unsigned* MISC = (volatile LAS unsigned*)(lds + LDS_BYTES - 16);
    if (tid < 4) MISC[tid] = 0u;
    __syncthreads();
    unsigned* BAR = (unsigned*)(ws + WS_CNT + 65536);
    const int lo = P.ph_lo, hi = P.ph_hi;
    const float* x = P.in[0]; const float* ctx = P.in[2]; const float* normg = P.in[6];
    float* MOD = (float*)(ws + WS_MOD);
    bf16_t* XL = (bf16_t*)(ws + WS_XL);
    unsigned* CNT = (unsigned*)(ws + WS_CNT);
    bf16_t* H = (bf16_t*)(ws + WS_H); bf16_t* BIG = (bf16_t*)(ws + WS_BIG); bf16_t* A2 = (bf16_t*)(ws + WS_A2); bf16_t* OL = (bf16_t*)(ws + WS_OL);
#ifndef REPMASK
#define REPMASK 0
#endif
#define IN(k) (lo <= (k) && (k) < hi)
#define REP(k) _Pragma("unroll") for (int rep_ = 0; rep_ <= ((REPMASK >> (k)) & 1); ++rep_)
#define SEAM(k) do { if (IN(k)) xcd_barrier(xbar); } while (0)
#define MODP(layer, r, slot) (MOD + (size_t)((layer) * 5 + (r)) * NMOD + (slot) * DM)
#define NG(layer, k) (normg + ((layer) * 4 + (k)) * DM)

    if (IN(0)) REP(0) {
        for (int i = bid * NTHREADS + tid; i < 4 * 4096; i += G * NTHREADS) CNT[i] = 0u;
        if (bid == 0) for (int i = tid; i < XCD_BAR_WORDS; i += NTHREADS) BAR[i] = 0u;
        p0_mod(P.in[1], P.in[3], P.in[4], P.in[5], MOD, lds, bid, G, tid);
        __syncthreads();
        p0_weights(P.in, ws, lds, bid, G, tid);
        __syncthreads();
    }
    grid.sync();
    const XcdBarrier xbar = xcd_barrier_post(BAR, MISC);
    if (IN(1)) REP(1) {
        f32x4 xn[8];
#define P1_SRC(row_) (((row_) % TKV) >= CTX ? x + (size_t)(((row_) / TKV) * SEQ + ((row_) % TKV) - CTX) * DM : ctx + (size_t)(((row_) / TKV) * CTX + ((row_) % TKV)) * DM)
#define P1_LOAD(row_) do { const float* s_ = P1_SRC(row_); _Pragma("unroll") for (int j = 0; j < 4; ++j) { xn[2 * j] = *(const f32x4*)(s_ + j * 512 + lane * 8); xn[2 * j + 1] = *(const f32x4*)(s_ + j * 512 + lane * 8 + 4); } } while (0)
        if (gw < MT) P1_LOAD(gw);
        for (int row = gw; row < MT; row += NGW) {
            const int b_ = row / TKV, pos = row % TKV; const int r = pos >= CTX ? b_ : 4;
            f32x4 xv[8]; float ss = 0.f;
#pragma unroll
            for (int i = 0; i < 8; ++i) { xv[i] = xn[i]; ss += (xv[i][0] * xv[i][0] + xv[i][1] * xv[i][1]) + (xv[i][2] * xv[i][2] + xv[i][3] * xv[i][3]); }
            if (row + NGW < MT) P1_LOAD(row + NGW);
            const float rstd = rsqrtf(wave_sum(ss) * (1.0f / DM) + EPS);
            const float* g_n = NG(0, 0); const float* shift = MODP(0, r, 0); const float* scale = MODP(0, r, 1); bf16_t* h = H + (size_t)row * DM;
#pragma unroll
            for (int j = 0; j < 4; ++j) { const int e0 = j * 512 + lane * 8; float hv[8];
                const f32x4 ga = *(const f32x4*)(g_n + e0), gb = *(const f32x4*)(g_n + e0 + 4), sa = *(const f32x4*)(scale + e0), sb = *(const f32x4*)(scale + e0 + 4),
                            ha = *(const f32x4*)(shift + e0), hb = *(const f32x4*)(shift + e0 + 4);
#pragma unroll
                for (int e = 0; e < 4; ++e) { hv[e] = xv[2 * j][e] * rstd * ga[e] * (1.0f + sa[e]) + ha[e]; hv[4 + e] = xv[2 * j + 1][e] * rstd * gb[e] * (1.0f + sb[e]) + hb[e]; }
                u32x4 w; w.x = pk2(hv[0], hv[1]); w.y = pk2(hv[2], hv[3]); w.z = pk2(hv[4], hv[5]); w.w = pk2(hv[6], hv[7]);
                *(u32x4*)(h + e0) = w; }
        }
#undef P1_LOAD
#undef P1_SRC
    }
    SEAM(1);
    if (IN(2)) REP(2) {
        pg8::Gemm g{H, (const bf16_t*)(ws + WS_WIN), MT, AR_IN, DM}; pg8::StaticOrder S; S.init(MT, AR_IN, G, bid);
        pg8::EpiAct<0> E{BIG, AR_IN, nullptr};
        pg8::gemm_phase<pg8::EpiAct<0>, pg8::StaticOrder, true, true>(lds, g, S, E);
    }
    SEAM(2);
    if (IN(3)) REP(3) {
        if (rep_ == 0) { if (G == 256) { if (bid >= 64) k_post(BIG, P.in[11], (bid - 64) * 8 + wave, 192 * 8, lane); } else k_post(BIG, P.in[11], gw, NGW, lane); }
        __syncthreads();
        rglru_pass<1>(P.in, ws, lds, bid, G, tid);
    }
    SEAM(3);
    if (IN(4)) {
        rglru_carry(ws, bid * NTHREADS + tid);
        xcd_barrier(xbar);
        for (int u = bid; u < 512; u += G) {
            const int bv = u & 255, jj = u >> 8, combo = bv & 7, local = bv >> 3, b = combo >> 1, kvh = combo & 1, idx = local * 2 + jj, hig = idx >> 4, qb = idx & 15, h = kvh * 4 + hig;
            att::q_prep<att::bf16>((att::bf16*)BIG + (size_t)(b * TKV + CTX + qb * 256) * AR_IN + h * 128, P.in[10], qb * 256);
        }
        for (int u0 = bid; u0 < 512 * (((REPMASK >> 4) & 1) + 1); u0 += G) { const int u = u0 & 511;
            const int bv = u & 255, jj = u >> 8, combo = bv & 7, local = bv >> 3, b = combo >> 1, kvh = combo & 1, idx = local * 2 + jj, hig = idx >> 4, qb = idx & 15, h = kvh * 4 + hig;
            const att::bf16* Qb = (const att::bf16*)BIG + (size_t)(b * TKV + CTX + qb * 256) * AR_IN + h * 128;
            const att::bf16* Kh = (const att::bf16*)BIG + (size_t)b * TKV * AR_IN + 1024 + kvh * 128; const att::bf16* Vh = (const att::bf16*)BIG + (size_t)b * TKV * AR_IN + 1280 + kvh * 128;
            att::bf16* Ob = (att::bf16*)A2 + (size_t)(b * SEQ + qb * 256) * DM + h * 128;
            att::attn_dense_body<att::bf16>(Qb, Kh, Vh, Ob, TKV, (char*)lds_raw, P.in[10], qb * 256);
            __syncthreads();
        }
        _Pragma("unroll") for (int r2_ = 0; r2_ <= ((REPMASK >> 18) & 1); ++r2_) rglru_pass2(ws, lds, bid, G, tid);
    }
    SEAM(4);
    if (IN(5)) {
        pg8::Gemm g{A2, (const bf16_t*)(ws + WS_WOUT), ML, DM, DM}; PanelOrder S{bid, G};
        EpiPanel<false, true> E{OL, CNT + 0 * 4096, x, NG(0, 1), MODP(0, 0, 2), XL, NG(0, 2), MODP(0, 0, 3), MODP(0, 0, 4), H};
        pg8::gemm_phase<EpiPanel<false, true>, PanelOrder, true, true>(lds, g, S, E);
    }
    SEAM(5);
    if (IN(7)) REP(7) {
        pg8::Gemm g{H, (const bf16_t*)(ws + WS_WFF1), ML, DFF, DM}; pg8::StaticOrder S; S.init(ML, DFF, G, bid);
        pg8::EpiAct<2> E{BIG, DFF, nullptr};
        pg8::gemm_phase<pg8::EpiAct<2>, pg8::StaticOrder, true, true>(lds, g, S, E);
    }
    SEAM(7);
    if (IN(8)) {
        pg8::Gemm g{BIG, (const bf16_t*)(ws + WS_WFF2), ML, DM, DFF}; PanelOrder S{bid, G};
        EpiPanel<true, true> E{OL, CNT + 1 * 4096, XL, NG(0, 3), MODP(0, 0, 5), XL, NG(1, 0), MODP(1, 0, 0), MODP(1, 0, 1), H};
        pg8::gemm_phase<EpiPanel<true, true>, PanelOrder, true, true>(lds, g, S, E);
    }
    SEAM(8);
    if (IN(10)) REP(10) {
        pg8::Gemm g{H, (const bf16_t*)(ws + WS_WGIN), ML, 4096, DM}; pg8::StaticOrder S; S.init(ML, 4096, G, bid);
        pg8::EpiAct<3> E{BIG, 4096, P.in[21], (float*)(ws + WS_PART)};
        pg8::gemm_phase<pg8::EpiAct<3>, pg8::StaticOrder, true, true>(lds, g, S, E);
    }
    SEAM(10);
    if (IN(12)) REP(12) { gm_spatial_pass(P.in, ws, lds, bid, G, tid); }
    SEAM(12);
    if (IN(13)) {
        pg8::Gemm g{A2, (const bf16_t*)(ws + WS_WGOUT), ML, DM, DM}; PanelOrder S{bid, G};
        EpiPanel<true, true> E{OL, CNT + 2 * 4096, XL, NG(1, 1), MODP(1, 0, 2), XL, NG(1, 2), MODP(1, 0, 3), MODP(1, 0, 4), H};
        pg8::gemm_phase<EpiPanel<true, true>, PanelOrder, true, true>(lds, g, S, E);
    }
    SEAM(13);
    if (IN(15)) REP(15) {
        pg8::Gemm g{H, (const bf16_t*)(ws + WS_WFF1) + (size_t)DM * DFF, ML, DFF, DM}; pg8::StaticOrder S; S.init(ML, DFF, G, bid);
        pg8::EpiAct<2> E{BIG, DFF, nullptr};
        pg8::gemm_phase<pg8::EpiAct<2>, pg8::StaticOrder, true, true>(lds, g, S, E);
    }
    SEAM(15);
    if (IN(16)) {
        pg8::Gemm g{BIG, (const bf16_t*)(ws + WS_WFF2) + (size_t)DM * DFF, ML, DM, DFF}; PanelOrder S{bid, G};
        EpiPanel<true, false> E{OL, CNT + 3 * 4096, XL, NG(1, 3), MODP(1, 0, 5), P.out, nullptr, nullptr, nullptr, nullptr};
        pg8::gemm_phase<EpiPanel<true, false>, PanelOrder, true, true>(lds, g, S, E);
    }
}

constexpr int NPHASE = 18;
#ifndef MK_PER_PHASE
#define MK_PER_PHASE 0
#endif
extern "C" void kernel_launch(void* const* d_in, const int* in_sizes, int n_in, void* d_out, int out_size, void* d_ws, size_t ws_size, hipStream_t stream) {
    static int grid = 0;
    if (grid == 0) {
        if (n_in != 27 || in_sizes[0] != ML * DM || out_size != ML * DM || ws_size < WS_END) { fprintf(stderr, "kernel_launch: unexpected shapes / workspace (n_in %d, ws %zu < %zu)\n", n_in, ws_size, (size_t)WS_END); grid = -1; return; }
        int dev = 0, cus = 0, per_cu = 0;
        if (hipGetDevice(&dev) != hipSuccess || hipDeviceGetAttribute(&cus, hipDeviceAttributeMultiprocessorCount, dev) != hipSuccess) { grid = -1; return; }
        if (hipFuncSetAttribute((const void*)mega, hipFuncAttributeMaxDynamicSharedMemorySize, LDS_BYTES) != hipSuccess) { fprintf(stderr, "kernel_launch: hipFuncSetAttribute failed\n"); grid = -1; return; }
        if (hipOccupancyMaxActiveBlocksPerMultiprocessor(&per_cu, (const void*)mega, NTHREADS, LDS_BYTES) != hipSuccess || per_cu < 1) { fprintf(stderr, "kernel_launch: occupancy query says %d\n", per_cu); per_cu = 1; }
        (void)hipGetLastError();
        grid = cus * 1;
    }
    if (grid < 0) return;
    Params p{};
    for (int i = 0; i < 27; ++i) p.in[i] = (const float*)d_in[i];
    p.out = (float*)d_out; p.ws = (unsigned char*)d_ws;
#if MK_PER_PHASE
    for (int ph = 0; ph < NPHASE; ++ph) { p.ph_lo = ph; p.ph_hi = ph + 1; hipLaunchKernelGGL(mega, dim3(grid), dim3(NTHREADS), LDS_BYTES, stream, p); }
#else
    p.ph_lo = 0; p.ph_hi = NPHASE;
    void* args[] = {&p};
    hipError_t e = hipLaunchCooperativeKernel((const void*)mega, dim3(grid), dim3(NTHREADS), args, LDS_BYTES, stream);
    if (e != hipSuccess) fprintf(stderr, "kernel_launch: cooperative launch failed: %s (grid %d)\n", hipGetErrorString(e), grid);
#endif
}
```

```cpp
#include <hip/hip_runtime.h>
#include <hip/hip_cooperative_groups.h>
#include <hip/hip_bf16.h>
#include <cstdio>
#include <cstdint>
namespace pg8 {
#define PG8_LAS __attribute__((address_space(3)))
typedef unsigned short bf16_t;
typedef short bf16x8 __attribute__((ext_vector_type(8)));
typedef float f32x4 __attribute__((ext_vector_type(4)));
typedef unsigned u32x4 __attribute__((ext_vector_type(4)));
constexpr int BM = 256, BK = 64, HALF = 128, HTB = HALF * BK * 2  , STAGE_BYTES = 8 * HTB, NXCD = 8, WGM = 8;

__host__ __device__ __forceinline__ int lds_byte(int r, int c) { const int st = (r >> 4) * 2 + (c >> 5), rr = r & 15, cc = c & 31, ob = rr * 64 + cc * 2; return st * 1024 + (ob ^ (((ob >> 9) & 1) << 5)); }
__host__ __device__ __forceinline__ void stage_rc(int b, int& R, int& C) { const int st = b / 1024, sb = b % 1024, swz = sb ^ (((sb >> 9) & 1) << 5); R = (st >> 1) * 16 + swz / 64; C = (st & 1) * 32 + (swz % 64) / 2; }
__host__ __device__ __forceinline__ int perm32(int rho) { const int n = rho >> 4, i = rho & 15; return 8 * (i >> 2) + 4 * n + (i & 3); }

struct Unit { int pm, pn; };
struct Gemm { const bf16_t* A; const bf16_t* Bt; int M, N, K; };

struct StaticOrder {
    int nM, nN, nwg, G, c;
    __host__ __device__ void init(int M, int N, int G_, int c_) { nM = M / BM; nN = N / BM; nwg = nM * nN; G = G_; c = c_; }
    __host__ __device__ bool next(int i, Unit& u) const {
        const long L = (long)i * G + c; if (L >= nwg) return false;
        int wgid = (int)L; { const int q = nwg / NXCD, r = nwg % NXCD, xcd = wgid % NXCD, off = wgid / NXCD; wgid = (xcd < r ? xcd * (q + 1) : r * (q + 1) + (xcd - r) * q) + off; }
        const int nig = WGM * nN, gid = wgid / nig, fm = gid * WGM, gsz = (nM - fm) < WGM ? (nM - fm) : WGM;
        u.pm = fm + ((wgid % nig) % gsz); u.pn = (wgid % nig) / gsz; return true;
    }
    __device__ __forceinline__ void a_ready(const Unit&) const {}
    __device__ __forceinline__ void done(const Unit&) const {}
};

__device__ __forceinline__ unsigned cvt_pk_bf16(float lo, float hi) { unsigned r; asm volatile("v_cvt_pk_bf16_f32 %0, %1, %2" : "=v"(r) : "v"(lo), "v"(hi)); return r; }
typedef float f32x2 __attribute__((ext_vector_type(2)));
__device__ __forceinline__ f32x2 gelu_pk(f32x2 v) {
    const f32x2 av = __builtin_elementwise_abs(v), d = av * 0.2316418882f + 1.0f;
    f32x2 t; t.x = __builtin_amdgcn_rcpf(d.x); t.y = __builtin_amdgcn_rcpf(d.y);
    f32x2 q = t * 0.5307027145f + (-0.7265760135f); q = q * t + 0.7107068705f; q = q * t + (-0.142248368f); q = q * t + 0.127414796f; q = q * t;
    const f32x2 s = (v * v) * (-0.72134752044f);
    f32x2 e; e.x = __builtin_amdgcn_exp2f(s.x); e.y = __builtin_amdgcn_exp2f(s.y);
    const f32x2 m = v * (q * e), r = v - m;
    f32x2 o; o.x = v.x < 0.f ? m.x : r.x; o.y = v.y < 0.f ? m.y : r.y; return o;
}

__device__ __forceinline__ float gelu_tanh(float x) {
    const float t = 0.7978845608028654f * (x + 0.044715f * x * x * x);
    return x * __builtin_amdgcn_rcpf(1.0f + __builtin_amdgcn_exp2f(-2.8853900817779268f * t));
}
template <int ACT  > struct EpiAct {
    static constexpr bool PERM = true, AFTER_DRAIN = false;
    bf16_t* O; int ldc; const float* bias; float* part;
    __device__ __forceinline__ void operator()(const f32x4 (&acc)[2][2][4][2], const Unit& u, int wr, int wc, int fr, int fq) const {
        const int row0 = u.pm * BM + wr * 64 + fr; const int col0 = u.pn * BM + wc * 32 + 8 * fq;
        f32x4 bv[2][2];
#pragma unroll
        for (int bj = 0; bj < 2; ++bj)
#pragma unroll
            for (int n = 0; n < 2; ++n) bv[bj][n] = bias ? *(const f32x4*)(bias + col0 + bj * HALF + 4 * n) : (f32x4){0.f, 0.f, 0.f, 0.f};
#pragma unroll
        for (int ai = 0; ai < 2; ++ai)
#pragma unroll
            for (int m = 0; m < 4; ++m) { bf16_t* rowp = O + (size_t)(row0 + ai * HALF + m * 16) * ldc + col0; float s1 = 0.f, s2 = 0.f;
#pragma unroll
                for (int bj = 0; bj < 2; ++bj) { f32x4 v0 = acc[ai][bj][m][0] + bv[bj][0], v1 = acc[ai][bj][m][1] + bv[bj][1];
                    if (ACT == 2) {
#pragma unroll
                        for (int e = 0; e < 4; ++e) { float a = fmaxf(v0[e], 0.f), b = fmaxf(v1[e], 0.f); v0[e] = a * a; v1[e] = b * b; } }
                    if (ACT == 3) {
#pragma unroll
                        for (int e = 0; e < 4; ++e) { v0[e] = gelu_tanh(v0[e]); v1[e] = gelu_tanh(v1[e]); s1 += v0[e] + v1[e]; s2 += v0[e] * v0[e] + v1[e] * v1[e]; } }
                    u32x4 w; w.x = cvt_pk_bf16(v0[0], v0[1]); w.y = cvt_pk_bf16(v0[2], v0[3]); w.z = cvt_pk_bf16(v1[0], v1[1]); w.w = cvt_pk_bf16(v1[2], v1[3]);
                    *(u32x4*)(rowp + bj * HALF) = w; }
                if (ACT == 3 && part && u.pn >= 8) { s1 += __shfl_xor(s1, 16); s1 += __shfl_xor(s1, 32); s2 += __shfl_xor(s2, 16); s2 += __shfl_xor(s2, 32);
                    if (fq == 0) *(f32x2*)(part + (((size_t)(row0 + ai * HALF + m * 16) * 8 + (u.pn - 8)) * 4 + wc) * 2) = (f32x2){s1, s2}; } }
    }
};
template <class Epi, class Sched, bool ALIGN_EPI = false, bool SP2 = false>
__device__ __forceinline__ void gemm_phase(PG8_LAS unsigned char* lds, const Gemm g, const Sched& S, const Epi& E) {
    const int tid = threadIdx.x, wid = __builtin_amdgcn_readfirstlane(tid >> 6), lane = tid & 63, wr = wid >> 2, wc = wid & 3, fr = lane & 15, fq = lane >> 4;
    const int K = g.K, nt = K / BK;
    unsigned voffA[2], voffB[2];
#pragma unroll
    for (int i = 0; i < 2; ++i) { int R, C; stage_rc(tid * 16 + i * 8192, R, C); const int Rb = Epi::PERM ? ((R & ~31) + perm32(R & 31)) : R;
        voffA[i] = (unsigned)(R * K + C) * 2u; voffB[i] = (unsigned)(Rb * K + C) * 2u; }
    const size_t kstep = (size_t)(BK * 2);
    const size_t hstep = (size_t)HALF * K * 2;
    const size_t tstep = 2 * hstep;
    const unsigned ldsw = (unsigned)wid * 1024u;
    const int aoff = lds_byte(wr * 64 + fr, fq * 8), boff = lds_byte(wc * 32 + fr, fq * 8);
#define PG8_SA(b, h) (((b) * 2 + (h)) * HTB)
#define PG8_SB(b, h) ((4 + (b) * 2 + (h)) * HTB)
#define PG8_STAGE(bufoff, gbase, voff) do { _Pragma("unroll") for (int _i = 0; _i < 2; ++_i) \
        __builtin_amdgcn_global_load_lds((const unsigned*)((const char*)(gbase) + (voff)[_i]), (PG8_LAS unsigned*)(lds + (bufoff) + ldsw + _i * 8192), 16, 0, 0); } while (0)
#define PG8_LDA(dst, b, h) do { _Pragma("unroll") for (int m = 0; m < 4; ++m) _Pragma("unroll") for (int k = 0; k < 2; ++k) dst[m][k] = *(const PG8_LAS bf16x8*)(lds + PG8_SA(b, h) + aoff + m * 2048 + k * 1024); } while (0)
#define PG8_LDB(dst, b, h) do { _Pragma("unroll") for (int n = 0; n < 2; ++n) _Pragma("unroll") for (int k = 0; k < 2; ++k) dst[n][k] = *(const PG8_LAS bf16x8*)(lds + PG8_SB(b, h) + boff + n * 2048 + k * 1024); } while (0)
#define PG8_MMA(ai, bj, At, Bt) do { __builtin_amdgcn_s_setprio(1); _Pragma("unroll") for (int m = 0; m < 4; ++m) _Pragma("unroll") for (int n = 0; n < 2; ++n) _Pragma("unroll") for (int k = 0; k < 2; ++k) \
        acc[ai][bj][m][n] = __builtin_amdgcn_mfma_f32_16x16x32_bf16(Bt[n][k], At[m][k], acc[ai][bj][m][n], 0, 0, 0); __builtin_amdgcn_s_setprio(0); } while (0)
#define PG8_WAIT_V(n) asm volatile("s_waitcnt vmcnt(" #n ")" ::: "memory")
#define PG8_WAIT_L(n) asm volatile("s_waitcnt lgkmcnt(" #n ")" ::: "memory")
#define PG8_BAR __builtin_amdgcn_s_barrier()
#define PG8_SCHED __builtin_amdgcn_sched_barrier(0)
    Unit cur, nxt; int ui = 0;
    if (!S.next(0, cur)) return;
    f32x4 acc[2][2][4][2];
#pragma unroll
    for (int a = 0; a < 2; ++a)
#pragma unroll
        for (int b = 0; b < 2; ++b)
#pragma unroll
            for (int m = 0; m < 4; ++m)
#pragma unroll
                for (int n = 0; n < 2; ++n) acc[a][b][m][n] = (f32x4){0.f, 0.f, 0.f, 0.f};
    bf16x8 At[4][2], B0[2][2], B1[2][2];
    const char* cA = (const char*)g.A + (size_t)cur.pm * tstep; const char* cB = (const char*)g.Bt + (size_t)cur.pn * tstep;
    S.a_ready(cur);
    if constexpr (SP2) {
        PG8_STAGE(PG8_SB(0, 0), cB, voffB); PG8_STAGE(PG8_SB(0, 1), cB + hstep, voffB); PG8_STAGE(PG8_SA(0, 0), cA, voffA); PG8_STAGE(PG8_SA(0, 1), cA + hstep, voffA);
        if (wr == 1) PG8_BAR;
        PG8_WAIT_V(2); PG8_BAR;
        PG8_STAGE(PG8_SB(1, 0), cB + kstep, voffB); PG8_STAGE(PG8_SA(1, 0), cA + kstep, voffA); PG8_STAGE(PG8_SB(1, 1), cB + hstep + kstep, voffB);
        PG8_WAIT_V(6); PG8_BAR;
    } else {
        PG8_STAGE(PG8_SB(0, 0), cB, voffB); PG8_STAGE(PG8_SA(0, 0), cA, voffA); PG8_STAGE(PG8_SB(0, 1), cB + hstep, voffB); PG8_STAGE(PG8_SA(0, 1), cA + hstep, voffA);
        if (wr == 1) PG8_BAR;
        PG8_WAIT_V(4); PG8_BAR;
        PG8_STAGE(PG8_SB(1, 0), cB + kstep, voffB); PG8_STAGE(PG8_SA(1, 0), cA + kstep, voffA); PG8_STAGE(PG8_SB(1, 1), cB + hstep + kstep, voffB);
        PG8_WAIT_V(6); PG8_BAR;
    }
    for (;;) {
        const bool has_next = S.next(ui + 1, nxt);
        const char* nA = has_next ? (const char*)g.A + (size_t)nxt.pm * tstep : cA; const char* nB = has_next ? (const char*)g.Bt + (size_t)nxt.pn * tstep : cB;
        for (int t = 0; t < nt; t += 2) {
            const bool last = (t == nt - 2);
            const char* a1 = cA + (size_t)(t + 1) * kstep;
            const char* a2 = last ? nA : cA + (size_t)(t + 2) * kstep; const char* b2 = last ? nB : cB + (size_t)(t + 2) * kstep;
            const char* a3 = a2 + kstep; const char* b3 = b2 + kstep;
            if (last && has_next) S.a_ready(nxt);
            if constexpr (SP2) {
            PG8_LDB(B0, 0, 0); PG8_LDB(B1, 0, 1); PG8_SCHED; PG8_LDA(At, 0, 0); PG8_STAGE(PG8_SA(1, 1), a1 + hstep, voffA);
            PG8_WAIT_V(8); PG8_WAIT_L(0); PG8_BAR; PG8_MMA(0, 0, At, B0); PG8_MMA(0, 1, At, B1); PG8_BAR; PG8_SCHED;
            PG8_LDA(At, 0, 1); PG8_STAGE(PG8_SB(0, 0), b2, voffB); PG8_STAGE(PG8_SB(0, 1), b2 + hstep, voffB); PG8_STAGE(PG8_SA(0, 0), a2, voffA);
            PG8_WAIT_V(8); PG8_WAIT_L(0); PG8_BAR; PG8_MMA(1, 0, At, B0); PG8_MMA(1, 1, At, B1); PG8_BAR; PG8_SCHED;
            PG8_LDB(B0, 1, 0); PG8_LDB(B1, 1, 1); PG8_SCHED; PG8_LDA(At, 1, 0); PG8_STAGE(PG8_SA(0, 1), a2 + hstep, voffA);
            PG8_WAIT_V(8); PG8_WAIT_L(0); PG8_BAR; PG8_MMA(0, 0, At, B0); PG8_MMA(0, 1, At, B1); PG8_BAR; PG8_SCHED;
            PG8_LDA(At, 1, 1); PG8_STAGE(PG8_SB(1, 0), b3, voffB); PG8_STAGE(PG8_SB(1, 1), b3 + hstep, voffB); PG8_STAGE(PG8_SA(1, 0), a3, voffA);
            PG8_WAIT_V(8); PG8_WAIT_L(0); PG8_BAR; PG8_MMA(1, 0, At, B0); PG8_MMA(1, 1, At, B1); PG8_BAR; PG8_SCHED;
            } else {
            PG8_LDB(B0, 0, 0); PG8_SCHED; PG8_LDA(At, 0, 0); PG8_STAGE(PG8_SA(1, 1), a1 + hstep, voffA);
            PG8_WAIT_L(8); PG8_BAR; PG8_WAIT_L(0); PG8_MMA(0, 0, At, B0); PG8_BAR; PG8_SCHED;
            PG8_LDB(B1, 0, 1); PG8_STAGE(PG8_SB(0, 0), b2, voffB);
            PG8_BAR; PG8_WAIT_L(0); PG8_MMA(0, 1, At, B1); PG8_BAR;
            PG8_LDA(At, 0, 1); PG8_STAGE(PG8_SA(0, 0), a2, voffA);
            PG8_BAR; PG8_WAIT_L(0); PG8_MMA(1, 0, At, B0); PG8_BAR; PG8_SCHED;
            PG8_STAGE(PG8_SB(0, 1), b2 + hstep, voffB);
            PG8_WAIT_V(6); PG8_BAR; PG8_MMA(1, 1, At, B1); PG8_BAR;
            PG8_LDB(B0, 1, 0); PG8_SCHED; PG8_LDA(At, 1, 0); PG8_STAGE(PG8_SA(0, 1), a2 + hstep, voffA);
            PG8_WAIT_L(8); PG8_BAR; PG8_WAIT_L(0); PG8_MMA(0, 0, At, B0); PG8_BAR; PG8_SCHED;
            PG8_LDB(B1, 1, 1); PG8_STAGE(PG8_SB(1, 0), b3, voffB);
            PG8_BAR; PG8_WAIT_L(0); PG8_MMA(0, 1, At, B1); PG8_BAR;
            PG8_LDA(At, 1, 1); PG8_STAGE(PG8_SA(1, 0), a3, voffA);
            PG8_BAR; PG8_WAIT_L(0); PG8_MMA(1, 0, At, B0); PG8_BAR; PG8_SCHED;
            PG8_STAGE(PG8_SB(1, 1), b3 + hstep, voffB);
            PG8_WAIT_V(6); PG8_BAR; PG8_MMA(1, 1, At, B1); PG8_BAR;
            }
        }
        if constexpr (ALIGN_EPI) { if (wr == 0) PG8_BAR; }
        if constexpr (!Epi::AFTER_DRAIN) { E(acc, cur, wr, wc, fr, fq); S.done(cur); }
        if (!has_next) break;
#pragma unroll
        for (int a = 0; a < 2; ++a)
#pragma unroll
            for (int b = 0; b < 2; ++b)
#pragma unroll
                for (int m = 0; m < 4; ++m)
#pragma unroll
                    for (int n = 0; n < 2; ++n) acc[a][b][m][n] = (f32x4){0.f, 0.f, 0.f, 0.f};
        cur = nxt; cA = nA; cB = nB; ++ui;
        if constexpr (ALIGN_EPI) { if (wr == 1) PG8_BAR; }
    }
    PG8_WAIT_V(0);
    if constexpr (!ALIGN_EPI) { if (wr == 0) PG8_BAR; }
    PG8_BAR;
    if constexpr (Epi::AFTER_DRAIN) { E.fused(acc, cur, wr, wc, fr, fq, lds, wid, lane); S.done(cur); }
#undef PG8_SA
#undef PG8_SB
#undef PG8_STAGE
#undef PG8_LDA
#undef PG8_LDB
#undef PG8_MMA
#undef PG8_WAIT_V
#undef PG8_WAIT_L
#undef PG8_BAR
#undef PG8_SCHED
}
}
namespace att {
using bf16 = __hip_bfloat16;
constexpr int   D = 128, NW = 8, QBLK = 32, KVBLK = 64;
constexpr float SCALE = 0.088388347648318440f;
constexpr float THR = 8.f;
constexpr int SDEPTH = 2;
constexpr int LDQ = 3584, LDK = 3584, LDO = 2048;
constexpr size_t SHM_V = KVBLK * D * 2, SHM_K = KVBLK * D * 2, SHM_ATTN = 2 * SHM_V + 2 * SHM_K + NW * 64 * 4;
using bf16x8 = __attribute__((ext_vector_type(8))) short;
using s16x4  = __attribute__((ext_vector_type(4))) short;
using f32x16 = __attribute__((ext_vector_type(16))) float;
using f32x8  = __attribute__((ext_vector_type(8))) float;
using u32x4  = __attribute__((ext_vector_type(4))) unsigned;
#define KSWZ(row, colB) ((row) * 256 + ((colB) ^ (((row) & 7) << 4)))
#define SBAR() __builtin_amdgcn_sched_barrier(0)
__device__ __forceinline__ int crow(int r, int hi) { return (r & 3) + 8 * (r >> 2) + 4 * hi; }
__device__ __forceinline__ unsigned cvtpk(float lo, float hi) {
  unsigned r; asm volatile("v_cvt_pk_bf16_f32 %0, %1, %2" : "=v"(r) : "v"(lo), "v"(hi)); return r;
}
template <typename TIn> struct Stage;
template <> struct Stage<bf16>  { using T = bf16x8;
  __device__ static __forceinline__ T ld8(const bf16* p) { return *reinterpret_cast<const bf16x8*>(p); }
  __device__ static __forceinline__ bf16x8 tobf(T x) { return x; } };
template <> struct Stage<float> { using T = f32x8;
  __device__ static __forceinline__ T ld8(const float* p) { return *reinterpret_cast<const f32x8*>(p); }
  __device__ static __forceinline__ bf16x8 tobf(T x) {
    u32x4 w = {cvtpk(x[0], x[1]), cvtpk(x[2], x[3]), cvtpk(x[4], x[5]), cvtpk(x[6], x[7])}; return *reinterpret_cast<bf16x8*>(&w); } };

__device__ __forceinline__ void partialSM(f32x16& p0, f32x16& p1, float& m_reg, float& mn, float& alpha) {
  constexpr float C = SCALE * 1.4426950408889634f;
  float pmax = p0[0]; for (int r = 1; r < 16; ++r) pmax = fmaxf(pmax, p0[r]); for (int r = 0; r < 16; ++r) pmax = fmaxf(pmax, p1[r]);
  { auto rr = __builtin_amdgcn_permlane32_swap(__float_as_uint(pmax), __float_as_uint(pmax), false, false);
    pmax = fmaxf(__uint_as_float(rr[0]), __uint_as_float(rr[1])); }
  if (__builtin_expect(__all(pmax - m_reg <= THR / SCALE), 1)) { mn = m_reg; alpha = 1.f; }
  else { mn = fmaxf(m_reg, pmax); alpha = __builtin_amdgcn_exp2f((m_reg - mn) * C); m_reg = mn; }
  float mnC = -mn * C;
  for (int r = 0; r < 16; ++r) p0[r] = fmaf(p0[r], C, mnC); for (int r = 0; r < 16; ++r) p1[r] = fmaf(p1[r], C, mnC);
  for (int r = 0; r < 16; ++r) p0[r] = __builtin_amdgcn_exp2f(p0[r]);
}
__device__ __forceinline__ void finishSM(f32x16& p0, f32x16& p1, float alpha, float& l_reg, bf16x8& pa0, bf16x8& pa1, bf16x8& pa2, bf16x8& pa3) {
  for (int r = 0; r < 16; ++r) p1[r] = __builtin_amdgcn_exp2f(p1[r]);
  float ps = 0; for (int r = 0; r < 16; ++r) ps += p0[r]; for (int r = 0; r < 16; ++r) ps += p1[r];
  { auto rr = __builtin_amdgcn_permlane32_swap(__float_as_uint(ps), __float_as_uint(ps), false, false);
    ps = __uint_as_float(rr[0]) + __uint_as_float(rr[1]); }
  l_reg = l_reg * alpha + ps;
#define PK4(P, BASE, OUT) do { unsigned a0 = cvtpk(P[BASE + 0], P[BASE + 1]), a1 = cvtpk(P[BASE + 2], P[BASE + 3]);   \
    unsigned b0 = cvtpk(P[BASE + 4], P[BASE + 5]), b1 = cvtpk(P[BASE + 6], P[BASE + 7]);                              \
    auto r0 = __builtin_amdgcn_permlane32_swap(a0, b0, false, false); auto r1 = __builtin_amdgcn_permlane32_swap(a1, b1, false, false); \
    u32x4 w = {r0[0], r1[0], r0[1], r1[1]}; OUT = *reinterpret_cast<bf16x8*>(&w); } while (0)
  PK4(p0, 0, pa0); PK4(p0, 8, pa1); PK4(p1, 0, pa2); PK4(p1, 8, pa3);
#undef PK4
}
__device__ __forceinline__ void qkt(f32x16& p0, f32x16& p1, const bf16* Ks, const bf16x8* qr, int r32, int hi) {
  p0 = f32x16{}; p1 = f32x16{};
  for (int d0 = 0; d0 < 8; ++d0) { int cb = (d0 * 16 + hi * 8) * 2;
    bf16x8 b0 = *reinterpret_cast<const bf16x8*>((const char*)Ks + KSWZ(r32, cb));
    bf16x8 b1 = *reinterpret_cast<const bf16x8*>((const char*)Ks + KSWZ(32 + r32, cb));
    p0 = __builtin_amdgcn_mfma_f32_32x32x16_bf16(b0, qr[d0], p0, 0, 0, 0);
    p1 = __builtin_amdgcn_mfma_f32_32x32x16_bf16(b1, qr[d0], p1, 0, 0, 0); }
}
__device__ __forceinline__ int v_st(int k, int c) { const int kk = (k & ~0xC) | ((k & 4) << 1) | ((k & 8) >> 1); return ((kk >> 3) * 4 + (c >> 5)) * 512 + ((kk & 7) * 32 + (c & 31)) * 2; }
__device__ __forceinline__ int v_rd_base(int lane) { return ((lane & 3) << 3) | (((lane >> 2) & 3) << 6) | (((lane >> 4) & 1) << 5) | (((lane >> 5) & 1) << 8); }
constexpr int v_rd_off(int d0, int ks, int half) { return d0 * 512 + ks * 4096 + half * 2048; }
template <int OFF> __device__ __forceinline__ s16x4 tr_read(int vb) {
  s16x4 r; asm volatile("ds_read_b64_tr_b16 %0, %1 offset:%2" : "=&v"(r) : "v"(vb), "i"(OFF) : "memory"); return r;
}
template <int D0> __device__ __forceinline__ void pv_one(f32x16& od, int vb, bf16x8 pa0, bf16x8 pa1, bf16x8 pa2, bf16x8 pa3) {
  const s16x4 l0 = tr_read<v_rd_off(D0, 0, 0)>(vb), h0 = tr_read<v_rd_off(D0, 0, 1)>(vb), l1 = tr_read<v_rd_off(D0, 1, 0)>(vb), h1 = tr_read<v_rd_off(D0, 1, 1)>(vb);
  const s16x4 l2 = tr_read<v_rd_off(D0, 2, 0)>(vb), h2 = tr_read<v_rd_off(D0, 2, 1)>(vb), l3 = tr_read<v_rd_off(D0, 3, 0)>(vb), h3 = tr_read<v_rd_off(D0, 3, 1)>(vb);
  asm volatile("s_waitcnt lgkmcnt(0)" ::: "memory"); SBAR();
#define PK(L, H) (bf16x8){L[0], L[1], L[2], L[3], H[0], H[1], H[2], H[3]}
  od = __builtin_amdgcn_mfma_f32_32x32x16_bf16(pa0, PK(l0, h0), od, 0, 0, 0);
  od = __builtin_amdgcn_mfma_f32_32x32x16_bf16(pa1, PK(l1, h1), od, 0, 0, 0);
  od = __builtin_amdgcn_mfma_f32_32x32x16_bf16(pa2, PK(l2, h2), od, 0, 0, 0);
  od = __builtin_amdgcn_mfma_f32_32x32x16_bf16(pa3, PK(l3, h3), od, 0, 0, 0);
#undef PK
}
__device__ __forceinline__ void pv_d0(f32x16* o, int vb, bf16x8 pa0, bf16x8 pa1, bf16x8 pa2, bf16x8 pa3) {
  pv_one<0>(o[0], vb, pa0, pa1, pa2, pa3); pv_one<1>(o[1], vb, pa0, pa1, pa2, pa3); pv_one<2>(o[2], vb, pa0, pa1, pa2, pa3); pv_one<3>(o[3], vb, pa0, pa1, pa2, pa3);
}

constexpr int QS_OFF = 69632;
template <typename TQ>
__device__ __forceinline__ void q_prep(TQ* Qb, const float* __restrict__ qg, int tq0) {
  using SQ = Stage<TQ>;
  const int tid = threadIdx.x, wid = tid >> 6, lane = tid & 63, r32 = lane & 31; int hi = lane >> 5;
  asm volatile("" : "+v"(hi));
  TQ* Qw = Qb + (long)(wid * QBLK + r32) * LDQ + hi * 8;
  bf16x8 raw[8]; float ss = 0.f;
#pragma unroll
  for (int d0 = 0; d0 < 8; ++d0) { raw[d0] = SQ::tobf(SQ::ld8(Qw + d0 * 16));
#pragma unroll
    for (int i = 0; i < 8; ++i) { const float v = __uint_as_float(((unsigned)(unsigned short)raw[d0][i]) << 16); ss += v * v; } }
  ss += __shfl_xor(ss, 32);
  const float rstd = rsqrtf(ss * (1.0f / 128.0f) + 1e-6f);
  const int tq = tq0 + wid * QBLK + r32;
#pragma unroll
  for (int ax = 0; ax < 2; ++ax) {
    const float fp = (float)(ax == 0 ? (tq >> 6) : (tq & 63));
#pragma unroll
    for (int dd = 0; dd < 2; ++dd) {
      const int da = ax * 4 + dd, db = da + 2; float oa[8], ob[8];
#pragma unroll
      for (int i = 0; i < 8; ++i) { const float freq = exp2f(-(float)(dd * 16 + hi * 8 + i) * (13.287712379549449f / 32.0f));
        float ar = fp * freq * 0.15915494309189535f; ar -= floorf(ar);
        const float sn = __builtin_amdgcn_sinf(ar), cs = __builtin_amdgcn_cosf(ar);
        const float x1 = __uint_as_float(((unsigned)(unsigned short)raw[da][i]) << 16) * rstd * qg[da * 16 + hi * 8 + i];
        const float x2 = __uint_as_float(((unsigned)(unsigned short)raw[db][i]) << 16) * rstd * qg[db * 16 + hi * 8 + i];
        oa[i] = x1 * cs - x2 * sn; ob[i] = x2 * cs + x1 * sn; }
      u32x4 wa = {cvtpk(oa[0], oa[1]), cvtpk(oa[2], oa[3]), cvtpk(oa[4], oa[5]), cvtpk(oa[6], oa[7])}, wb = {cvtpk(ob[0], ob[1]), cvtpk(ob[2], ob[3]), cvtpk(ob[4], ob[5]), cvtpk(ob[6], ob[7])};
      *reinterpret_cast<u32x4*>(Qw + da * 16) = wa; *reinterpret_cast<u32x4*>(Qw + db * 16) = wb;
      SBAR();
    }
  }
}
template <typename TQ>
__device__ __forceinline__ void attn_dense_body(const TQ* __restrict__ Qb, const bf16* __restrict__ Kh, const bf16* __restrict__ Vh,
                                                bf16* __restrict__ Ob, int seq, char* lds, const float* __restrict__ qg, int tq0) {
  using St = Stage<bf16>; using SQ = Stage<TQ>;
  const int tid = threadIdx.x, wid = tid >> 6, lane = tid & 63, r32 = lane & 31, hi = lane >> 5;
  bf16* V_lds = (bf16*)lds; bf16* K_lds = (bf16*)(lds + 2 * SHM_V);
  float* ws = (float*)(lds + 2 * SHM_V + 2 * SHM_K) + wid * 64; float* li_l = ws; float* al_l = ws + 32;
  float m_reg = -1e30f, l_reg = 0; f32x16 o[4] = {}; bf16x8 qr[8];
  const TQ* Qw = Qb + (long)(wid * QBLK + r32) * LDQ + hi * 8;
#pragma unroll
  for (int d0 = 0; d0 < 8; ++d0) qr[d0] = SQ::tobf(SQ::ld8(Qw + d0 * 16));
  const int sr = tid >> 4, sc = (tid & 15) * 8, vst0 = v_st(sr, sc), vst1 = v_st(32 + sr, sc);
  const int vb0 = (int)(uintptr_t)V_lds + v_rd_base(lane);
  struct { typename St::T vs0, vs1, ks0, ks1; } sr_[SDEPTH];
#define SLOAD(i, k0) do { sr_[i].vs0 = St::ld8(&Vh[(long)((k0) + sr) * LDK + sc]); sr_[i].vs1 = St::ld8(&Vh[(long)((k0) + 32 + sr) * LDK + sc]); \
    sr_[i].ks0 = St::ld8(&Kh[(long)((k0) + sr) * LDK + sc]); sr_[i].ks1 = St::ld8(&Kh[(long)((k0) + 32 + sr) * LDK + sc]); } while (0)
#define SWRITE(b, i) do { *(bf16x8*)((char*)V_lds + (b) * SHM_V + vst0) = St::tobf(sr_[i].vs0);          \
    *(bf16x8*)((char*)V_lds + (b) * SHM_V + vst1) = St::tobf(sr_[i].vs1); int kc = sc * 2;               \
    *(bf16x8*)((char*)K_lds + (b) * SHM_K + KSWZ(sr, kc)) = St::tobf(sr_[i].ks0);                       \
    *(bf16x8*)((char*)K_lds + (b) * SHM_K + KSWZ(32 + sr, kc)) = St::tobf(sr_[i].ks1); } while (0)
#define SWAIT() do { if constexpr (SDEPTH == 2) asm volatile("s_waitcnt vmcnt(4)" ::: "memory"); else asm volatile("s_waitcnt vmcnt(0)" ::: "memory"); } while (0)
#define RESC(a) do { if (__any((a) < 1.f)) { if (hi == 0) al_l[r32] = (a); asm volatile("s_waitcnt lgkmcnt(0)" ::: "memory"); \
    for (int d = 0; d < 4; ++d) for (int r = 0; r < 16; ++r) o[d][r] *= al_l[crow(r, hi)]; } } while (0)
  f32x16 pA0, pA1, pB0, pB1; float mnA, mnB, alA, alB; bf16x8 pa0, pa1, pa2, pa3; const int NT = seq / KVBLK;
  constexpr int SE = 0, SO = SDEPTH - 1;
  SLOAD(SE, 0); asm volatile("s_waitcnt vmcnt(0)" ::: "memory"); SWRITE(0, SE); __syncthreads();
  qkt(pA0, pA1, K_lds, qr, r32, hi); partialSM(pA0, pA1, m_reg, mnA, alA);
  SLOAD(SO, KVBLK); if constexpr (SDEPTH == 2) { if (2 < NT) SLOAD(SE, 2 * KVBLK); }
  SWAIT(); SWRITE(1, SO); __syncthreads();
  for (int j = 1; j + 1 < NT; j += 2) {
    SBAR(); qkt(pB0, pB1, (bf16*)((char*)K_lds + SHM_K), qr, r32, hi);
    finishSM(pA0, pA1, alA, l_reg, pa0, pa1, pa2, pa3); SBAR();
    SLOAD(SO, (j + SDEPTH) * KVBLK); SBAR();
    pv_d0(o, vb0, pa0, pa1, pa2, pa3); partialSM(pB0, pB1, m_reg, mnB, alB);
    __syncthreads(); SWAIT(); SWRITE(0, SE);
    RESC(alB); __syncthreads();
    SBAR(); qkt(pA0, pA1, K_lds, qr, r32, hi);
    finishSM(pB0, pB1, alB, l_reg, pa0, pa1, pa2, pa3); SBAR();
    if (SDEPTH == 1 || j + 3 < NT) SLOAD(SE, (j + 1 + SDEPTH) * KVBLK); SBAR();
    pv_d0(o, vb0 + (int)SHM_V, pa0, pa1, pa2, pa3); partialSM(pA0, pA1, m_reg, mnA, alA);
    __syncthreads(); SWAIT(); SWRITE(1, SO);
    RESC(alA); __syncthreads();
  }
  SBAR(); qkt(pB0, pB1, (bf16*)((char*)K_lds + SHM_K), qr, r32, hi);
  finishSM(pA0, pA1, alA, l_reg, pa0, pa1, pa2, pa3); SBAR();
  pv_d0(o, vb0, pa0, pa1, pa2, pa3); partialSM(pB0, pB1, m_reg, mnB, alB);
  __syncthreads(); RESC(alB);
  finishSM(pB0, pB1, alB, l_reg, pa0, pa1, pa2, pa3); SBAR();
  pv_d0(o, vb0 + (int)SHM_V, pa0, pa1, pa2, pa3);
  if (hi == 0) li_l[r32] = l_reg; asm volatile("s_waitcnt lgkmcnt(0)" ::: "memory");
  float rli[16];
#pragma unroll
  for (int r = 0; r < 16; ++r) rli[r] = __builtin_amdgcn_rcpf(li_l[crow(r, hi)]);
  bf16* Ow = Ob + (long)(wid * QBLK) * LDO;
#pragma unroll
  for (int r = 0; r < 16; ++r) { int orow = crow(r, hi);
    for (int d0 = 0; d0 < 4; ++d0) Ow[(long)orow * LDO + d0 * 32 + r32] = __float2bfloat16(o[d0][r] * rli[r]); }
#undef SLOAD
#undef SWRITE
#undef SWAIT
#undef RESC
}
#undef KSWZ
#undef SBAR
}
namespace cg = cooperative_groups;
#define LAS __attribute__((address_space(3)))
typedef unsigned short bf16_t;
typedef short bf16x8 __attribute__((ext_vector_type(8)));
typedef float f32x4 __attribute__((ext_vector_type(4)));
typedef unsigned u32x4 __attribute__((ext_vector_type(4)));
typedef unsigned u32x2 __attribute__((ext_vector_type(2)));

constexpr int DM = 2048, NB = 4, SEQ = 4096, CTX = 256, ML = NB * SEQ, MC = NB * CTX, MT = ML + MC, TKV = CTX + SEQ;
constexpr int AR_IN = 3584, DFF = 8192, NMOD = 6 * DM;
constexpr float EPS = 1e-6f;
constexpr size_t MiB = 1u << 20;
constexpr size_t WS_MOD = 0, WS_SUMA = 1 * MiB, WS_SUMH = 4 * MiB, WS_STATS = 7 * MiB, WS_WA = 8 * MiB, WS_WX = 8 * MiB + 512 * 1024, WS_WSP = 9 * MiB,
                 WS_WIN = 10 * MiB, WS_WOUT = 24 * MiB, WS_WFF1 = 32 * MiB, WS_WFF2 = 96 * MiB, WS_WGIN = 160 * MiB, WS_WGOUT = 176 * MiB,
                 WS_H = 184 * MiB, WS_KN = 252 * MiB, WS_VN = 261 * MiB, WS_A2 = 270 * MiB, WS_OL = 334 * MiB, WS_BIG = 398 * MiB, WS_CARRY = 654 * MiB, WS_PART = 656 * MiB, WS_CNT = 660 * MiB, WS_XL = 661 * MiB, WS_END = 725 * MiB;
constexpr int LDS_BYTES = 147456;
constexpr int NTHREADS = 512;

struct Params { const float* in[27]; float* out; unsigned char* ws; int ph_lo, ph_hi; };

__device__ __forceinline__ float bf2f(unsigned short h) { return __uint_as_float((unsigned)h << 16); }
__device__ __forceinline__ unsigned pk2(float lo, float hi) { unsigned r; asm volatile("v_cvt_pk_bf16_f32 %0, %1, %2" : "=v"(r) : "v"(lo), "v"(hi)); return r; }
__device__ __forceinline__ float wave_sum(float v) {
#pragma unroll
    for (int o = 1; o < 64; o <<= 1) v += __shfl_xor(v, o);
    return v;
}
__device__ __forceinline__ float sigm(float x) { return 1.0f / (1.0f + __expf(-x)); }
__device__ __forceinline__ float gelu_t(float x) { return pg8::gelu_tanh(x); }
#define LDS_WAIT() asm volatile("s_waitcnt lgkmcnt(0)" ::: "memory")

__device__ __forceinline__ void p0_mod(const float* c, const float* cctx, const float* wmod, const float* bmod, float* MOD, LAS unsigned char* lds, int bid, int G, int tid) {
    LAS float* S = (LAS float*)lds;
    LAS float* R = S + 5 * DM;
    if (bid >= 192) return;
    for (int i = tid; i < 5 * DM; i += NTHREADS) { const float v = i < 4 * DM ? c[i] : cctx[i - 4 * DM]; S[i] = v / (1.0f + __expf(-v)); }
    __syncthreads();
    for (int it = bid; it < 192; it += G) {
        const int layer = it / 96, n0 = (it % 96) * 128, cgp = tid & 31, ks = tid >> 5;
        const float* wp = wmod + (size_t)layer * DM * NMOD + (size_t)(ks * 128) * NMOD + n0 + cgp * 4;
        f32x4 acc[5];
#pragma unroll
        for (int r = 0; r < 5; ++r) acc[r] = (f32x4){0.f, 0.f, 0.f, 0.f};
#pragma unroll 8
        for (int k = 0; k < 128; ++k) { const f32x4 w = *(const f32x4*)(wp + (size_t)k * NMOD); const int kk = ks * 128 + k;
#pragma unroll
            for (int r = 0; r < 5; ++r) acc[r] += S[r * DM + kk] * w; }
#pragma unroll
        for (int r = 0; r < 5; ++r) *(LAS f32x4*)&R[(ks * 5 + r) * 128 + cgp * 4] = acc[r];
        __syncthreads();
        for (int o = tid; o < 640; o += NTHREADS) { const int r = o >> 7, n = o & 127; float s = 0.f;
#pragma unroll
            for (int k2 = 0; k2 < 16; ++k2) s += R[(k2 * 5 + r) * 128 + n];
            MOD[(size_t)(layer * 5 + r) * NMOD + n0 + n] = s + bmod[layer * NMOD + n0 + n]; }
        __syncthreads();
    }
}
__device__ __forceinline__ void p0_transpose_item(const float* W, int K, int N, bf16_t* WT, LAS float* scr, int item, int lane) {
    const int nblk = N / 32, kb = item / nblk, nb = item % nblk, k0 = 64 * kb, n0 = 32 * nb;
#pragma unroll 8
    for (int i = 0; i < 32; ++i) { const int kk = 2 * i + (lane >> 5); scr[kk * 33 + (lane & 31)] = W[(size_t)(k0 + kk) * N + n0 + (lane & 31)]; }
    LDS_WAIT(); asm volatile("" ::: "memory");
    const int c = lane & 7;
#pragma unroll
    for (int j = 0; j < 4; ++j) { const int n = (lane >> 3) + 8 * j; const LAS float* s = scr + (8 * c) * 33 + n;
        u32x4 o; o.x = pk2(s[0 * 33], s[1 * 33]); o.y = pk2(s[2 * 33], s[3 * 33]); o.z = pk2(s[4 * 33], s[5 * 33]); o.w = pk2(s[6 * 33], s[7 * 33]);
        *(u32x4*)(WT + (size_t)(n0 + n) * K + k0 + 8 * c) = o; }
    LDS_WAIT(); asm volatile("" ::: "memory");
}
__device__ __forceinline__ void p0_weights(const float* const* in, unsigned char* ws, LAS unsigned char* lds, int bid, int G, int tid) {
    const int wave = __builtin_amdgcn_readfirstlane(tid >> 6), lane = tid & 63;
    LAS float* scr = (LAS float*)(lds + wave * 8448);
    const int gw = bid * 8 + wave, NGW = G * 8;
    constexpr int I0 = 3584, I1 = 2048, I2 = 8192, I3 = 8192, I4 = 8192, I5 = 8192, I6 = 4096, I7 = 2048, I8 = 128, I9 = 128;
    constexpr int NIT = I0 + I1 + I2 + I3 + I4 + I5 + I6 + I7 + I8 + I9;
    int it0 = gw, it1 = NIT, step = NGW;
    if (G == 256) { it0 = (bid < 192 ? bid * 154 : 192 * 154 + (bid - 192) * 239); it1 = it0 + (bid < 192 ? 154 : 239); if (it1 > NIT) it1 = NIT; it0 += wave; step = 8; }
    for (int it = it0; it < it1; it += step) {
        int r = it;
        if (r < I2) { p0_transpose_item(in[7], DM, DFF, (bf16_t*)(ws + WS_WFF1), scr, r, lane); continue; } r -= I2;
        if (r < I4) { p0_transpose_item(in[8], DFF, DM, (bf16_t*)(ws + WS_WFF2), scr, r, lane); continue; } r -= I4;
        if (r < I3) { p0_transpose_item(in[7] + (size_t)DM * DFF, DM, DFF, (bf16_t*)(ws + WS_WFF1) + (size_t)DM * DFF, scr, r, lane); continue; } r -= I3;
        if (r < I5) { p0_transpose_item(in[8] + (size_t)DM * DFF, DFF, DM, (bf16_t*)(ws + WS_WFF2) + (size_t)DM * DFF, scr, r, lane); continue; } r -= I5;
        if (r < I0) { p0_transpose_item(in[9], DM, AR_IN, (bf16_t*)(ws + WS_WIN), scr, r, lane); continue; } r -= I0;
        if (r < I1) { p0_transpose_item(in[19], DM, DM, (bf16_t*)(ws + WS_WOUT), scr, r, lane); continue; } r -= I1;
        if (r < I6) { p0_transpose_item(in[20], DM, 4096, (bf16_t*)(ws + WS_WGIN), scr, r, lane); continue; } r -= I6;
        if (r < I7) { p0_transpose_item(in[26], DM, DM, (bf16_t*)(ws + WS_WGOUT), scr, r, lane); continue; } r -= I7;
        if (r < I8) { const int mi = r >> 3; p0_transpose_item(in[14] + (size_t)mi * 16384, 128, 128, (bf16_t*)(ws + WS_WA) + (size_t)mi * 16384, scr, r & 7, lane); continue; } r -= I8;
        { const int mi = r >> 3; p0_transpose_item(in[16] + (size_t)mi * 16384, 128, 128, (bf16_t*)(ws + WS_WX) + (size_t)mi * 16384, scr, r & 7, lane); }
    }
    const float* wsp = in[24]; bf16_t* WSP = (bf16_t*)(ws + WS_WSP);
    for (int i = (bid * NTHREADS + tid) * 4; i < 16 * 128 * 128; i += G * NTHREADS * 4) { const f32x4 v = *(const f32x4*)(wsp + i); u32x2 o; o.x = pk2(v[0], v[1]); o.y = pk2(v[2], v[3]); *(u32x2*)(WSP + i) = o; }
}

template <bool RES16, bool OUT16>
__device__ __forceinline__ void row_op(const void* res_, const bf16_t* o, const float* g_o, const float* gate, void* xl_out_,
                                       const float* g_n, const float* shift, const float* scale, bf16_t* h, int lane) {
    float x[32];
    if (RES16) { const bf16_t* res = (const bf16_t*)res_;
#pragma unroll
        for (int j = 0; j < 4; ++j) { const u32x4 w = *(const u32x4*)(res + j * 512 + lane * 8);
#pragma unroll
            for (int e = 0; e < 4; ++e) { x[j * 8 + 2 * e] = __uint_as_float(w[e] << 16); x[j * 8 + 2 * e + 1] = __uint_as_float(w[e] & 0xffff0000u); } }
    } else { const float* res = (const float*)res_;
#pragma unroll
    for (int j = 0; j < 4; ++j) { const float* rp = res + j * 512 + lane * 8; const f32x4 a = *(const f32x4*)rp, b = *(const f32x4*)(rp + 4);
        x[j * 8 + 0] = a[0]; x[j * 8 + 1] = a[1]; x[j * 8 + 2] = a[2]; x[j * 8 + 3] = a[3]; x[j * 8 + 4] = b[0]; x[j * 8 + 5] = b[1]; x[j * 8 + 6] = b[2]; x[j * 8 + 7] = b[3]; }
    }
    if (o) {
        float ov[32]; float ss = 0.f;
#pragma unroll
        for (int j = 0; j < 4; ++j) { const u32x4 w = *(const u32x4*)(o + j * 512 + lane * 8);
#pragma unroll
            for (int e = 0; e < 4; ++e) { ov[j * 8 + 2 * e] = __uint_as_float(w[e] << 16); ov[j * 8 + 2 * e + 1] = __uint_as_float(w[e] & 0xffff0000u); } }
#pragma unroll
        for (int i = 0; i < 32; ++i) ss += ov[i] * ov[i];
        const float rstd = rsqrtf(wave_sum(ss) * (1.0f / DM) + EPS);
#pragma unroll
        for (int j = 0; j < 4; ++j) { const int e0 = j * 512 + lane * 8;
            const f32x4 ga = *(const f32x4*)(g_o + e0), gb = *(const f32x4*)(g_o + e0 + 4), ta = *(const f32x4*)(gate + e0), tb = *(const f32x4*)(gate + e0 + 4);
#pragma unroll
            for (int e = 0; e < 4; ++e) { x[j * 8 + e] += ta[e] * (ov[j * 8 + e] * rstd * ga[e]); x[j * 8 + 4 + e] += tb[e] * (ov[j * 8 + 4 + e] * rstd * gb[e]); } }
    }
    if (xl_out_) {
        if (OUT16) { bf16_t* xl_out = (bf16_t*)xl_out_;
#pragma unroll
            for (int j = 0; j < 4; ++j) { u32x4 w; w.x = pk2(x[j * 8 + 0], x[j * 8 + 1]); w.y = pk2(x[j * 8 + 2], x[j * 8 + 3]); w.z = pk2(x[j * 8 + 4], x[j * 8 + 5]); w.w = pk2(x[j * 8 + 6], x[j * 8 + 7]);
                *(u32x4*)(xl_out + j * 512 + lane * 8) = w;
#pragma unroll
                for (int e = 0; e < 4; ++e) { x[j * 8 + 2 * e] = __uint_as_float(w[e] << 16); x[j * 8 + 2 * e + 1] = __uint_as_float(w[e] & 0xffff0000u); } }
        } else { float* xl_out = (float*)xl_out_;
#pragma unroll
        for (int j = 0; j < 4; ++j) { float* wp = xl_out + j * 512 + lane * 8;
            *(f32x4*)wp = (f32x4){x[j * 8 + 0], x[j * 8 + 1], x[j * 8 + 2], x[j * 8 + 3]}; *(f32x4*)(wp + 4) = (f32x4){x[j * 8 + 4], x[j * 8 + 5], x[j * 8 + 6], x[j * 8 + 7]}; }
        }
    }
    if (h) {
        float ss = 0.f;
#pragma unroll
        for (int i = 0; i < 32; ++i) ss += x[i] * x[i];
        const float rstd = rsqrtf(wave_sum(ss) * (1.0f / DM) + EPS);
#pragma unroll
        for (int j = 0; j < 4; ++j) { const int e0 = j * 512 + lane * 8; float hv[8];
            const f32x4 ga = *(const f32x4*)(g_n + e0), gb = *(const f32x4*)(g_n + e0 + 4), sa = *(const f32x4*)(scale + e0), sb = *(const f32x4*)(scale + e0 + 4),
                        ha = *(const f32x4*)(shift + e0), hb = *(const f32x4*)(shift + e0 + 4);
#pragma unroll
            for (int e = 0; e < 4; ++e) { hv[e] = x[j * 8 + e] * rstd * ga[e] * (1.0f + sa[e]) + ha[e]; hv[4 + e] = x[j * 8 + 4 + e] * rstd * gb[e] * (1.0f + sb[e]) + hb[e]; }
            u32x4 w; w.x = pk2(hv[0], hv[1]); w.y = pk2(hv[2], hv[3]); w.z = pk2(hv[4], hv[5]); w.w = pk2(hv[6], hv[7]);
            *(u32x4*)(h + e0) = w; }
    }
}

struct PanelOrder {
    int c, G;
    __device__ __forceinline__ bool next(int i, pg8::Unit& u) const { if (i >= 2 || G != 256) return false; const int xcd = c & 7, slot = c >> 3; u.pm = i * 32 + xcd * 4 + (slot >> 3); u.pn = slot & 7; return true; }
    __device__ __forceinline__ void a_ready(const pg8::Unit&) const {}
    __device__ __forceinline__ void done(const pg8::Unit&) const {}
};
template <bool RES16, bool OUT16> struct EpiPanel {
    static constexpr bool PERM = true, AFTER_DRAIN = false;
    bf16_t* O; unsigned* cnt;
    const void* res; const float* g_o; const float* gate; void* xl_out; const float* g_n; const float* shift; const float* scale; bf16_t* H;
    __device__ __forceinline__ void operator()(const pg8::f32x4 (&acc)[2][2][4][2], const pg8::Unit& u, int wr, int wc, int fr, int fq) const {
        const int row0 = u.pm * 256 + wr * 64 + fr, col0 = u.pn * 256 + wc * 32 + 8 * fq;
#pragma unroll
        for (int ai = 0; ai < 2; ++ai)
#pragma unroll
            for (int m = 0; m < 4; ++m) { bf16_t* rowp = O + (size_t)(row0 + ai * 128 + m * 16) * DM + col0;
#pragma unroll
                for (int bj = 0; bj < 2; ++bj) { const pg8::f32x4 v0 = acc[ai][bj][m][0], v1 = acc[ai][bj][m][1];
                    u32x4 w; w.x = pk2(v0[0], v0[1]); w.y = pk2(v0[2], v0[3]); w.z = pk2(v1[0], v1[1]); w.w = pk2(v1[2], v1[3]);
                    asm volatile("global_store_dwordx4 %0, %1, off sc1\n\ts_nop 2" :: "v"(rowp + bj * 128), "v"(w) : "memory"); } }
        asm volatile("s_waitcnt vmcnt(0)" ::: "memory");
        __builtin_amdgcn_s_barrier();
        if (threadIdx.x == 0) {
            unsigned* cw = cnt + 64 * u.pm;
            __hip_atomic_fetch_add(cw, 1u, __ATOMIC_RELAXED, __HIP_MEMORY_SCOPE_AGENT);
            unsigned spins = 0;
            while (__hip_atomic_load(cw, __ATOMIC_RELAXED, __HIP_MEMORY_SCOPE_AGENT) < 8u) { __builtin_amdgcn_s_sleep(2); if (++spins > (1u << 18)) break; }
            __builtin_amdgcn_fence(__ATOMIC_ACQUIRE, "agent");
            asm volatile("s_waitcnt vmcnt(0)" ::: "memory");
        }
        __builtin_amdgcn_s_barrier();
        asm volatile("" ::: "memory");
        const int wave = __builtin_amdgcn_readfirstlane(threadIdx.x >> 6), lane = threadIdx.x & 63;
#pragma unroll 1
        for (int k = 0; k < 4; ++k) { const int row = u.pm * 256 + u.pn * 32 + wave * 4 + k, b = row / SEQ;
            row_op<RES16, OUT16>((const char*)res + (size_t)row * DM * (RES16 ? 2 : 4), O + (size_t)row * DM, g_o, gate + (size_t)b * NMOD, (char*)xl_out + (size_t)row * DM * (OUT16 ? 2 : 4), g_n, shift + (size_t)b * NMOD, scale + (size_t)b * NMOD, H ? H + (size_t)row * DM : nullptr, lane); }
    }
};

struct RowSS {
    float* xb; unsigned* cnt;
    __device__ __forceinline__ void run(const pg8::f32x4 (&v)[2][2][4][2], const pg8::Unit& u, int wr, int wc, int fr, int fq, LAS unsigned char* xl, int wid, int lane) const {
        LAS float* Pp = (LAS float*)xl;
        LAS float* S = (LAS float*)(xl + 4096);
#pragma unroll
        for (int ai = 0; ai < 2; ++ai)
#pragma unroll
            for (int mm = 0; mm < 4; ++mm) { float s = 0.f;
#pragma unroll
                for (int bj = 0; bj < 2; ++bj)
#pragma unroll
                    for (int n = 0; n < 2; ++n) { const pg8::f32x4 t = v[ai][bj][mm][n]; s += (t[0] * t[0] + t[1] * t[1]) + (t[2] * t[2] + t[3] * t[3]); }
                s += __shfl_xor(s, 16); s += __shfl_xor(s, 32);
                if (fq == 0) Pp[(ai * 128 + wr * 64 + mm * 16 + fr) * 4 + wc] = s; }
        asm volatile("s_waitcnt lgkmcnt(0)" ::: "memory"); __builtin_amdgcn_s_barrier(); asm volatile("" ::: "memory");
        const int row = wid * 32 + (lane & 31);
        if (lane < 32) { const f32x4 p4 = *(const LAS f32x4*)&Pp[row * 4];
            __hip_atomic_store(xb + ((size_t)u.pm * 256 + row) * 8 + u.pn, (p4[0] + p4[1]) + (p4[2] + p4[3]), __ATOMIC_RELAXED, __HIP_MEMORY_SCOPE_AGENT); }
        asm volatile("s_waitcnt vmcnt(0)" ::: "memory");
        if (lane == 0) __hip_atomic_fetch_add(cnt + 64 * u.pm, 1u, __ATOMIC_RELAXED, __HIP_MEMORY_SCOPE_AGENT);
        if (wid == 0) { unsigned spins = 0;
            while ((unsigned)__builtin_amdgcn_readfirstlane(__hip_atomic_load(cnt + 64 * u.pm, __ATOMIC_RELAXED, __HIP_MEMORY_SCOPE_AGENT)) < 64u) { __builtin_amdgcn_s_sleep(1); if (++spins > (1u << 18)) break; }
            __builtin_amdgcn_fence(__ATOMIC_ACQUIRE, "agent"); }
        asm volatile("s_waitcnt vmcnt(0) lgkmcnt(0)" ::: "memory"); __builtin_amdgcn_s_barrier(); asm volatile("" ::: "memory");
        if (lane < 32) { const float* sl = xb + ((size_t)u.pm * 256 + row) * 8; const f32x4 a = *(const f32x4*)sl, b = *(const f32x4*)(sl + 4);
            S[row] = rsqrtf(((a[0] + a[1]) + (a[2] + a[3]) + (b[0] + b[1]) + (b[2] + b[3])) * (1.0f / DM) + EPS); }
        asm volatile("s_waitcnt lgkmcnt(0)" ::: "memory"); __builtin_amdgcn_s_barrier(); asm volatile("" ::: "memory");
    }
};
template <bool RES16, bool OUT16> struct EpiPanelReg {
    static constexpr bool PERM = true, AFTER_DRAIN = false;
    RowSS e1, e2; LAS unsigned char* xl;
    const void* res; const float* g_o; const float* gate; void* xl_out; const float* g_n; const float* shift; const float* scale; bf16_t* H;
    __device__ __forceinline__ void operator()(pg8::f32x4 (&acc)[2][2][4][2], const pg8::Unit& u, int wr, int wc, int fr, int fq) const {
        asm volatile("" : "+v"(fr), "+v"(fq));
        const int wid = __builtin_amdgcn_readfirstlane(threadIdx.x >> 6), lane = threadIdx.x & 63;
        const LAS float* S = (const LAS float*)(xl + 4096);
        const int bb = (u.pm * 256) / SEQ, colb = u.pn * 256 + wc * 32 + 8 * fq;
        e1.run(acc, u, wr, wc, fr, fq, xl, wid, lane);
        {
            f32x4 c1[2][2];
#pragma unroll
            for (int bj = 0; bj < 2; ++bj)
#pragma unroll
                for (int n = 0; n < 2; ++n) { const int c = colb + bj * 128 + 4 * n; c1[bj][n] = *(const f32x4*)(gate + (size_t)bb * NMOD + c) * *(const f32x4*)(g_o + c); }
#pragma unroll
            for (int ai = 0; ai < 2; ++ai)
#pragma unroll
                for (int mm = 0; mm < 4; ++mm) { const int r = ai * 128 + wr * 64 + mm * 16 + fr; const float rs = S[r]; const size_t ro = (size_t)(u.pm * 256 + r) * DM + colb;
#pragma unroll
                    for (int bj = 0; bj < 2; ++bj) { f32x4 x0, x1;
                        if (RES16) { const u32x4 w = *(const u32x4*)((const bf16_t*)res + ro + bj * 128);
                            x0 = (f32x4){__uint_as_float(w.x << 16), __uint_as_float(w.x & 0xffff0000u), __uint_as_float(w.y << 16), __uint_as_float(w.y & 0xffff0000u)};
                            x1 = (f32x4){__uint_as_float(w.z << 16), __uint_as_float(w.z & 0xffff0000u), __uint_as_float(w.w << 16), __uint_as_float(w.w & 0xffff0000u)}; }
                        else { x0 = *(const f32x4*)((const float*)res + ro + bj * 128); x1 = *(const f32x4*)((const float*)res + ro + bj * 128 + 4); }
                        x0 += c1[bj][0] * (acc[ai][bj][mm][0] * rs); x1 += c1[bj][1] * (acc[ai][bj][mm][1] * rs);
                        if (OUT16) { u32x4 w; w.x = pk2(x0[0], x0[1]); w.y = pk2(x0[2], x0[3]); w.z = pk2(x1[0], x1[1]); w.w = pk2(x1[2], x1[3]);
                            *(u32x4*)((bf16_t*)xl_out + ro + bj * 128) = w;
                            x0 = (f32x4){__uint_as_float(w.x << 16), __uint_as_float(w.x & 0xffff0000u), __uint_as_float(w.y << 16), __uint_as_float(w.y & 0xffff0000u)};
                            x1 = (f32x4){__uint_as_float(w.z << 16), __uint_as_float(w.z & 0xffff0000u), __uint_as_float(w.w << 16), __uint_as_float(w.w & 0xffff0000u)}; }
                        else { *(f32x4*)((float*)xl_out + ro + bj * 128) = x0; *(f32x4*)((float*)xl_out + ro + bj * 128 + 4) = x1; }
                        acc[ai][bj][mm][0] = x0; acc[ai][bj][mm][1] = x1; }
                    asm volatile("" ::: "memory"); }
        }
        if (H) {
            e2.run(acc, u, wr, wc, fr, fq, xl, wid, lane);
            f32x4 c2[2][2], c3[2][2];
#pragma unroll
            for (int bj = 0; bj < 2; ++bj)
#pragma unroll
                for (int n = 0; n < 2; ++n) { const int c = colb + bj * 128 + 4 * n; c2[bj][n] = *(const f32x4*)(g_n + c) * (*(const f32x4*)(scale + (size_t)bb * NMOD + c) + 1.0f); c3[bj][n] = *(const f32x4*)(shift + (size_t)bb * NMOD + c); }
#pragma unroll
            for (int ai = 0; ai < 2; ++ai)
#pragma unroll
                for (int mm = 0; mm < 4; ++mm) { const int r = ai * 128 + wr * 64 + mm * 16 + fr; const float rs = S[r]; const size_t ro = (size_t)(u.pm * 256 + r) * DM + colb;
#pragma unroll
                    for (int bj = 0; bj < 2; ++bj) { const f32x4 h0 = acc[ai][bj][mm][0] * rs * c2[bj][0] + c3[bj][0], h1 = acc[ai][bj][mm][1] * rs * c2[bj][1] + c3[bj][1];
                        u32x4 w; w.x = pk2(h0[0], h0[1]); w.y = pk2(h0[2], h0[3]); w.z = pk2(h1[0], h1[1]); w.w = pk2(h1[2], h1[3]);
                        *(u32x4*)(H + ro + bj * 128) = w; }
                    asm volatile("" ::: "memory"); }
        }
    }
};

__device__ __forceinline__ void k_post(bf16_t* PROJ, const float* kg, int gw, int NGW, int lane) {
    const int half = lane >> 5, l = lane & 31, head = l >> 4, c = l & 15;
    const int dm = c * 8, dother = dm ^ 32;
    float gown[8], goth[8];
#pragma unroll
    for (int i = 0; i < 8; ++i) { gown[i] = kg[dm + i]; goth[i] = kg[dother + i]; }
    const float sgn = (c & 4) ? 1.f : -1.f;
    for (int rp = gw; rp < MT / 2; rp += NGW) {
        const int row = rp * 2 + half, pos = row % TKV; const bool latent = pos >= CTX; const int t = pos - CTX;
        bf16_t* kp = PROJ + (size_t)row * AR_IN + 1024 + head * 128 + dm;
        const u32x4 raw = *(const u32x4*)kp;
        u32x4 oth;
#pragma unroll
        for (int e = 0; e < 4; ++e) oth[e] = (unsigned)__shfl_xor((int)raw[e], 4);
        float v[8], w[8]; float ss = 0.f;
#pragma unroll
        for (int e = 0; e < 4; ++e) { v[2 * e] = __uint_as_float(raw[e] << 16); v[2 * e + 1] = __uint_as_float(raw[e] & 0xffff0000u); w[2 * e] = __uint_as_float(oth[e] << 16); w[2 * e + 1] = __uint_as_float(oth[e] & 0xffff0000u); }
#pragma unroll
        for (int i = 0; i < 8; ++i) ss += v[i] * v[i];
        ss += __shfl_xor(ss, 1); ss += __shfl_xor(ss, 2); ss += __shfl_xor(ss, 4); ss += __shfl_xor(ss, 8);
        const float rstd = rsqrtf(ss * (1.0f / 128.0f) + EPS);
        const float apos = (float)((c < 8) ? (t >> 6) : (t & 63));
        float o[8];
#pragma unroll
        for (int i = 0; i < 8; ++i) { float cs = 1.f, sn = 0.f;
            if (latent) { const float freq = exp2f(-(float)(8 * (c & 3) + i) * (13.287712379549449f / 32.0f)); float ar = apos * freq * 0.15915494309189535f; ar -= floorf(ar);
                sn = __builtin_amdgcn_sinf(ar); cs = __builtin_amdgcn_cosf(ar); }
            o[i] = (v[i] * rstd * gown[i]) * cs + sgn * (w[i] * rstd * goth[i]) * sn; }
        u32x4 ov; ov.x = pk2(o[0], o[1]); ov.y = pk2(o[2], o[3]); ov.z = pk2(o[4], o[5]); ov.w = pk2(o[6], o[7]);
        *(u32x4*)kp = ov;
    }
}

constexpr int NCH = 34;
__device__ __forceinline__ float sigm_fast(float x) { return __builtin_amdgcn_rcpf(1.0f + __builtin_amdgcn_exp2f(-1.4426950408889634f * x)); }
template <int PASS>
__device__ __forceinline__ void rglru_pass(const float* const* in, unsigned char* ws, LAS unsigned char* lds, int bid, int G, int tid) {
    asm volatile("" : "+v"(tid));
    const bf16_t* PROJ = (const bf16_t*)(ws + WS_BIG);
    float* SUMA = (float*)(ws + WS_SUMA); float* SUMH = (float*)(ws + WS_SUMH); const float* CARRY = (const float*)(ws + WS_CARRY);
    const bf16_t* WA = (const bf16_t*)(ws + WS_WA); const bf16_t* WX = (const bf16_t*)(ws + WS_WX);
    bf16_t* A2 = (bf16_t*)(ws + WS_A2);
    u32x4* AB0 = (u32x4*)(ws + WS_H); u32x4* AB1 = (u32x4*)(ws + WS_OL);
    const float* conv_w = in[12]; const float* conv_b = in[13]; const float* ba = in[15]; const float* bx = in[17]; const float* lam = in[18];
    LAS bf16_t* XA = (LAS bf16_t*)lds;
    LAS bf16_t* GL = (LAS bf16_t*)(lds + 34816);
    const int lane = tid & 63, wave = __builtin_amdgcn_readfirstlane(tid >> 6), quad = lane >> 4, l15 = lane & 15, ch = 16 * wave + l15;
    LAS float* HF = (LAS float*)(lds + 69632) + wave * 2048 + lane;
    constexpr int NT = (PASS == 1 ? 136 : 128) * 8;
    int cur_nb = -1;
    bf16x8 wfa[2][4], wfx[2][4]; float bav[2], bxv[2], spv[2];
    const int cs8 = (tid & 15) * 8, g4 = tid >> 4;
    u32x4 xr[7], glr[4];
#define RG_DECODE(tt_, nb_, b_, j_, sb_, len_, gc_) do { nb_ = (tt_) & 7; int rest_ = (tt_) >> 3; \
        if (PASS == 1 && rest_ < 8) { b_ = rest_ >> 1; j_ = rest_ & 1; sb_ = b_ * TKV; len_ = CTX; gc_ = j_; } \
        else { if (PASS == 1) rest_ -= 8; b_ = rest_ >> 5; j_ = rest_ & 31; sb_ = b_ * TKV + CTX; len_ = SEQ; gc_ = 2 + j_; } } while (0)
#define RG_LOAD(tt_) do { int nb_, b_, j_, sb_, len_, gc_; RG_DECODE(tt_, nb_, b_, j_, sb_, len_, gc_); (void)gc_; const int cg_ = nb_ * 128 + cs8; \
        _Pragma("unroll") for (int r = 0; r < 7; ++r) { const int tq_ = j_ * 128 + 4 * g4 + r - 2; \
            xr[r] = (tq_ >= 0 && tq_ < len_) ? *(const u32x4*)(PROJ + (size_t)(sb_ + tq_) * AR_IN + 1536 + cg_) : (u32x4){0u, 0u, 0u, 0u}; } \
        } while (0)
    if (bid < NT) RG_LOAD(bid);
    for (int t = bid; t < NT; t += G) {
        int nb, b, j, seqbase, len, gc; RG_DECODE(t, nb, b, j, seqbase, len, gc); (void)len;
        const int t0 = j * 128, chg = nb * 128 + ch;
        if (nb != cur_nb) {
            cur_nb = nb;
#pragma unroll
            for (int d = 0; d < 2; ++d) {
                const bf16_t* wa = WA + ((size_t)(d * 8 + nb) * 128 + ch) * 128 + quad * 8; const bf16_t* wx = WX + ((size_t)(d * 8 + nb) * 128 + ch) * 128 + quad * 8;
#pragma unroll
                for (int ks = 0; ks < 4; ++ks) { wfa[d][ks] = *(const bf16x8*)(wa + 32 * ks); wfx[d][ks] = *(const bf16x8*)(wx + 32 * ks); }
                bav[d] = ba[d * 1024 + chg]; bxv[d] = bx[d * 1024 + chg]; spv[d] = 11.541560327111707f * log1pf(__expf(-lam[d * 1024 + chg]));
            }
        }
        if (PASS == 2) {
#pragma unroll
            for (int tk = 0; tk < 4; ++tk) glr[tk] = *(const u32x4*)(PROJ + (size_t)(seqbase + t0 + 4 * g4 + tk) * AR_IN + 2560 + nb * 128 + cs8);
        }
        float cf = 0.f, cb = 0.f;
        if (PASS == 2) { cf = CARRY[((size_t)(0 * NB + b) * 32 + j) * 1024 + chg]; cb = CARRY[((size_t)(1 * NB + b) * 32 + j) * 1024 + chg]; }
        __syncthreads();
        {
            const int cg = nb * 128 + cs8;
            f32x4 cw[4][2]; const f32x4 cb0 = *(const f32x4*)(conv_b + cg), cb1 = *(const f32x4*)(conv_b + cg + 4);
#pragma unroll
            for (int jt = 0; jt < 4; ++jt) { cw[jt][0] = *(const f32x4*)(conv_w + jt * 1024 + cg); cw[jt][1] = *(const f32x4*)(conv_w + jt * 1024 + cg + 4); }
#pragma unroll
            for (int tk = 0; tk < 4; ++tk) {
                f32x4 y0 = cb0, y1 = cb1;
#pragma unroll
                for (int jt = 0; jt < 4; ++jt) { const u32x4 w = xr[tk + jt];
                    y0[0] += cw[jt][0][0] * __uint_as_float(w[0] << 16); y0[1] += cw[jt][0][1] * __uint_as_float(w[0] & 0xffff0000u);
                    y0[2] += cw[jt][0][2] * __uint_as_float(w[1] << 16); y0[3] += cw[jt][0][3] * __uint_as_float(w[1] & 0xffff0000u);
                    y1[0] += cw[jt][1][0] * __uint_as_float(w[2] << 16); y1[1] += cw[jt][1][1] * __uint_as_float(w[2] & 0xffff0000u);
                    y1[2] += cw[jt][1][2] * __uint_as_float(w[3] << 16); y1[3] += cw[jt][1][3] * __uint_as_float(w[3] & 0xffff0000u); }
                u32x4 o; o.x = pk2(y0[0], y0[1]); o.y = pk2(y0[2], y0[3]); o.z = pk2(y1[0], y1[1]); o.w = pk2(y1[2], y1[3]);
                *(LAS u32x4*)(XA + (4 * g4 + tk) * 136 + cs8) = o;
            }
            if (PASS == 2) {
#pragma unroll
                for (int tk = 0; tk < 4; ++tk) *(LAS u32x4*)(GL + (4 * g4 + tk) * 136 + cs8) = glr[tk];
            }
        }
        __syncthreads();
        if (t + G < NT) RG_LOAD(t + G);
        {
            float S = cf, AT = 1.f;
#pragma unroll 2
            for (int st = 0; st < 8; ++st) {
                f32x4 ca = {0.f, 0.f, 0.f, 0.f}, cx = {0.f, 0.f, 0.f, 0.f};
#pragma unroll
                for (int ks = 0; ks < 4; ++ks) { const bf16x8 af = *(const LAS bf16x8*)(XA + (16 * st + l15) * 136 + 32 * ks + quad * 8);
                    ca = __builtin_amdgcn_mfma_f32_16x16x32_bf16(af, wfa[0][ks], ca, 0, 0, 0); cx = __builtin_amdgcn_mfma_f32_16x16x32_bf16(af, wfx[0][ks], cx, 0, 0, 0); }
                float a[4], bq[4];
                u32x4 abw;
#pragma unroll
                for (int jj = 0; jj < 4; ++jj) { const float r = sigm_fast(ca[jj] + bav[0]), ig = sigm_fast(cx[jj] + bxv[0]);
                    const unsigned wl = pk2(-r * spv[0], 0.f) & 0xffffu; a[jj] = __builtin_amdgcn_exp2f(__uint_as_float(wl << 16));
                    const float xv = bf2f(XA[(16 * st + 4 * quad + jj) * 136 + ch]); const unsigned wb = pk2(__builtin_amdgcn_sqrtf(fmaxf(1.0f - a[jj] * a[jj], 0.f)) * (ig * xv), 0.f) << 16;
                    bq[jj] = __uint_as_float(wb); abw[jj] = wl | wb; }
                if (gc >= 2) AB0[((((size_t)(b * 32 + j) * 8 + nb) * 8 + wave) * 8 + st) * 64 + lane] = abw;
                float A = a[0], H = bq[0];
#pragma unroll
                for (int jj = 1; jj < 4; ++jj) { H = a[jj] * H + bq[jj]; A *= a[jj]; }
                { const float Ap = __shfl_up(A, 16), Hp = __shfl_up(H, 16); if (quad >= 1) { H = A * Hp + H; A = Ap * A; } }
                { const float Ap = __shfl_up(A, 32), Hp = __shfl_up(H, 32); if (quad >= 2) { H = A * Hp + H; A = Ap * A; } }
                float Ae = __shfl_up(A, 16), He = __shfl_up(H, 16); if (quad == 0) { Ae = 1.f; He = 0.f; }
                const float Atot = __shfl(A, 48 + l15), Htot = __shfl(H, 48 + l15);
                float s = Ae * S + He;
#pragma unroll
                for (int jj = 0; jj < 4; ++jj) { s = a[jj] * s + bq[jj]; if (PASS == 2) HF[(st * 4 + jj) * 64] = s; }
                S = Atot * S + Htot; AT *= Atot;
            }
            if (PASS == 1 && quad == 0) { const size_t o = ((size_t)(0 * NB + b) * NCH + gc) * 1024 + chg; SUMA[o] = AT; SUMH[o] = S; }
        }
        {
            float S = cb, AT = 1.f;
#pragma unroll 2
            for (int st = 7; st >= 0; --st) {
                f32x4 ca = {0.f, 0.f, 0.f, 0.f}, cx = {0.f, 0.f, 0.f, 0.f};
#pragma unroll
                for (int ks = 0; ks < 4; ++ks) { const bf16x8 af = *(const LAS bf16x8*)(XA + (16 * st + l15) * 136 + 32 * ks + quad * 8);
                    ca = __builtin_amdgcn_mfma_f32_16x16x32_bf16(af, wfa[1][ks], ca, 0, 0, 0); cx = __builtin_amdgcn_mfma_f32_16x16x32_bf16(af, wfx[1][ks], cx, 0, 0, 0); }
                float a[4], bq[4];
                u32x4 abw;
#pragma unroll
                for (int jj = 0; jj < 4; ++jj) { const float r = sigm_fast(ca[jj] + bav[1]), ig = sigm_fast(cx[jj] + bxv[1]);
                    const unsigned wl = pk2(-r * spv[1], 0.f) & 0xffffu; a[jj] = __builtin_amdgcn_exp2f(__uint_as_float(wl << 16));
                    const float xv = bf2f(XA[(16 * st + 4 * quad + jj) * 136 + ch]); const unsigned wb = pk2(__builtin_amdgcn_sqrtf(fmaxf(1.0f - a[jj] * a[jj], 0.f)) * (ig * xv), 0.f) << 16;
                    bq[jj] = __uint_as_float(wb); abw[jj] = wl | wb; }
                if (gc >= 2) AB1[((((size_t)(b * 32 + j) * 8 + nb) * 8 + wave) * 8 + st) * 64 + lane] = abw;
                float A = a[3], H = bq[3];
#pragma unroll
                for (int jj = 2; jj >= 0; --jj) { H = a[jj] * H + bq[jj]; A *= a[jj]; }
                { const float Ap = __shfl_down(A, 16), Hp = __shfl_down(H, 16); if (quad <= 2) { H = A * Hp + H; A = Ap * A; } }
                { const float Ap = __shfl_down(A, 32), Hp = __shfl_down(H, 32); if (quad <= 1) { H = A * Hp + H; A = Ap * A; } }
                float Ae = __shfl_down(A, 16), He = __shfl_down(H, 16); if (quad == 3) { Ae = 1.f; He = 0.f; }
                const float Atot = __shfl(A, l15), Htot = __shfl(H, l15);
                float s = Ae * S + He;
#pragma unroll
                for (int jj = 3; jj >= 0; --jj) { s = a[jj] * s + bq[jj];
                    if (PASS == 2) { LAS bf16_t* gp = GL + (16 * st + 4 * quad + jj) * 136 + ch; const float o = (HF[(st * 4 + jj) * 64] + s) * gelu_t(bf2f(*gp));
                        *gp = (bf16_t)(pk2(o, 0.f) & 0xffffu); } }
                S = Atot * S + Htot; AT *= Atot;
            }
            if (PASS == 1 && quad == 0) { const size_t o = ((size_t)(1 * NB + b) * NCH + gc) * 1024 + chg; SUMA[o] = AT; SUMH[o] = S; }
        }
        if (PASS == 2) {
            __syncthreads();
#pragma unroll
            for (int tk = 0; tk < 4; ++tk) *(u32x4*)(A2 + (size_t)(b * SEQ + t0 + 4 * g4 + tk) * DM + 1024 + nb * 128 + cs8) = *(const LAS u32x4*)(GL + (4 * g4 + tk) * 136 + cs8);
        }
    }
    __syncthreads();
#undef RG_LOAD
#undef RG_DECODE
}
__device__ __forceinline__ void rglru_pass2(unsigned char* ws, LAS unsigned char* lds, int bid, int G, int tid) {
    asm volatile("" : "+v"(tid));
    const bf16_t* PROJ = (const bf16_t*)(ws + WS_BIG); const float* CARRY = (const float*)(ws + WS_CARRY); bf16_t* A2 = (bf16_t*)(ws + WS_A2);
    const u32x4* AB0 = (const u32x4*)(ws + WS_H); const u32x4* AB1 = (const u32x4*)(ws + WS_OL);
    LAS bf16_t* GL = (LAS bf16_t*)(lds + 34816);
    const int lane = tid & 63, wave = __builtin_amdgcn_readfirstlane(tid >> 6), quad = lane >> 4, l15 = lane & 15, ch = 16 * wave + l15;
    LAS float* HF = (LAS float*)(lds + 69632) + wave * 2048 + lane;
    const int cs8 = (tid & 15) * 8, g4 = tid >> 4;
    constexpr int NT = 128 * 8;
    u32x4 abf[8], abb[8];
#define AB_BASE(tt_) (((((size_t)((tt_) >> 3) * 8 + ((tt_) & 7)) * 8 + wave) * 8) * 64 + lane)
    if (bid < NT) {
#pragma unroll
        for (int st = 0; st < 8; ++st) { abf[st] = AB0[AB_BASE(bid) + st * 64]; abb[st] = AB1[AB_BASE(bid) + st * 64]; }
    }
    u32x4 glr[4]; float cfn = 0.f, cbn = 0.f;
#define P2_LOAD(tt_) do { const int nb_ = (tt_) & 7, rest_ = (tt_) >> 3, b_ = rest_ >> 5, j_ = rest_ & 31; \
        _Pragma("unroll") for (int tk = 0; tk < 4; ++tk) glr[tk] = *(const u32x4*)(PROJ + (size_t)(b_ * TKV + CTX + j_ * 128 + 4 * g4 + tk) * AR_IN + 2560 + nb_ * 128 + cs8); \
        cfn = CARRY[((size_t)(0 * NB + b_) * 32 + j_) * 1024 + nb_ * 128 + ch]; cbn = CARRY[((size_t)(1 * NB + b_) * 32 + j_) * 1024 + nb_ * 128 + ch]; } while (0)
    if (bid < NT) P2_LOAD(bid);
    for (int t = bid; t < NT; t += G) {
        const int nb = t & 7, rest = t >> 3, b = rest >> 5, j = rest & 31, t0 = j * 128;
        const float cf = cfn, cb = cbn;
        __syncthreads();
#pragma unroll
        for (int tk = 0; tk < 4; ++tk) *(LAS u32x4*)(GL + (4 * g4 + tk) * 136 + cs8) = glr[tk];
        __syncthreads();
        if (t + G < NT) P2_LOAD(t + G);
        {
            float S = cf;
#pragma unroll
            for (int st = 0; st < 8; ++st) {
                float a[4], bq[4];
#pragma unroll
                for (int jj = 0; jj < 4; ++jj) { a[jj] = __builtin_amdgcn_exp2f(__uint_as_float(abf[st][jj] << 16)); bq[jj] = __uint_as_float(abf[st][jj] & 0xffff0000u); }
                float A = a[0], H = bq[0];
#pragma unroll
                for (int jj = 1; jj < 4; ++jj) { H = a[jj] * H + bq[jj]; A *= a[jj]; }
                { const float Ap = __shfl_up(A, 16), Hp = __shfl_up(H, 16); if (quad >= 1) { H = A * Hp + H; A = Ap * A; } }
                { const float Ap = __shfl_up(A, 32), Hp = __shfl_up(H, 32); if (quad >= 2) { H = A * Hp + H; A = Ap * A; } }
                float Ae = __shfl_up(A, 16), He = __shfl_up(H, 16); if (quad == 0) { Ae = 1.f; He = 0.f; }
                const float Atot = __shfl(A, 48 + l15), Htot = __shfl(H, 48 + l15);
                float s = Ae * S + He;
#pragma unroll
                for (int jj = 0; jj < 4; ++jj) { s = a[jj] * s + bq[jj]; HF[(st * 4 + jj) * 64] = s; }
                S = Atot * S + Htot;
            }
        }
        if (t + G < NT) {
#pragma unroll
            for (int st = 0; st < 8; ++st) abf[st] = AB0[AB_BASE(t + G) + st * 64];
        }
        {
            float S = cb;
#pragma unroll
            for (int st = 7; st >= 0; --st) {
                float a[4], bq[4];
#pragma unroll
                for (int jj = 0; jj < 4; ++jj) { a[jj] = __builtin_amdgcn_exp2f(__uint_as_float(abb[st][jj] << 16)); bq[jj] = __uint_as_float(abb[st][jj] & 0xffff0000u); }
                float A = a[3], H = bq[3];
#pragma unroll
                for (int jj = 2; jj >= 0; --jj) { H = a[jj] * H + bq[jj]; A *= a[jj]; }
                { const float Ap = __shfl_down(A, 16), Hp = __shfl_down(H, 16); if (quad <= 2) { H = A * Hp + H; A = Ap * A; } }
                { const float Ap = __shfl_down(A, 32), Hp = __shfl_down(H, 32); if (quad <= 1) { H = A * Hp + H; A = Ap * A; } }
                float Ae = __shfl_down(A, 16), He = __shfl_down(H, 16); if (quad == 3) { Ae = 1.f; He = 0.f; }
                const float Atot = __shfl(A, l15), Htot = __shfl(H, l15);
                float s = Ae * S + He;
#pragma unroll
                for (int jj = 3; jj >= 0; --jj) { s = a[jj] * s + bq[jj];
                    LAS bf16_t* gp = GL + (16 * st + 4 * quad + jj) * 136 + ch; const float o = (HF[(st * 4 + jj) * 64] + s) * gelu_t(bf2f(*gp));
                    *gp = (bf16_t)(pk2(o, 0.f) & 0xffffu); }
                S = Atot * S + Htot;
            }
        }
        if (t + G < NT) {
#pragma unroll
            for (int st = 0; st < 8; ++st) abb[st] = AB1[AB_BASE(t + G) + st * 64];
        }
        __syncthreads();
#pragma unroll
        for (int tk = 0; tk < 4; ++tk) *(u32x4*)(A2 + (size_t)(b * SEQ + t0 + 4 * g4 + tk) * DM + 1024 + nb * 128 + cs8) = *(const LAS u32x4*)(GL + (4 * g4 + tk) * 136 + cs8);
    }
    __syncthreads();
#undef AB_BASE
#undef P2_LOAD
}
__device__ __forceinline__ void rglru_carry(unsigned char* ws, int gtid) {
    if (gtid >= 2 * NB * 1024) return;
    const int ch = gtid & 1023, b = (gtid >> 10) & 3, dir = gtid >> 12;
    const float* pa = (const float*)(ws + WS_SUMA) + (size_t)(dir * NB + b) * NCH * 1024 + ch; const float* ph = (const float*)(ws + WS_SUMH) + (size_t)(dir * NB + b) * NCH * 1024 + ch;
    float* cp = (float*)(ws + WS_CARRY) + (size_t)(dir * NB + b) * 32 * 1024 + ch;
    float A[NCH], Hh[NCH];
#pragma unroll
    for (int g = 0; g < NCH; ++g) { A[g] = pa[(size_t)g * 1024]; Hh[g] = ph[(size_t)g * 1024]; }
    float s = 0.f;
    if (dir == 0) {
#pragma unroll
        for (int g = 0; g < NCH; ++g) { if (g >= 2) cp[(size_t)(g - 2) * 1024] = s; s = A[g] * s + Hh[g]; }
    } else {
#pragma unroll
        for (int g = 1; g >= 0; --g) s = A[g] * s + Hh[g];
#pragma unroll
        for (int g = NCH - 1; g >= 2; --g) { cp[(size_t)(g - 2) * 1024] = s; s = A[g] * s + Hh[g]; }
    }
}

__device__ __forceinline__ void gm_stats_row(const bf16_t* Z, float* STATS, int row, int lane) {
    const bf16_t* vp = Z + (size_t)row * 4096 + 2048; float v[32]; float s = 0.f;
#pragma unroll
    for (int j = 0; j < 4; ++j) { const u32x4 w = *(const u32x4*)(vp + j * 512 + lane * 8);
#pragma unroll
        for (int e = 0; e < 4; ++e) { v[j * 8 + 2 * e] = __uint_as_float(w[e] << 16); v[j * 8 + 2 * e + 1] = __uint_as_float(w[e] & 0xffff0000u); } }
#pragma unroll
    for (int i = 0; i < 32; ++i) s += v[i];
    const float mean = wave_sum(s) * (1.0f / 2048.0f); float q = 0.f;
#pragma unroll
    for (int i = 0; i < 32; ++i) { const float d = v[i] - mean; q += d * d; }
    const float rstd = rsqrtf(wave_sum(q) * (1.0f / 2048.0f) + EPS);
    if (lane == 0) { STATS[2 * row] = mean; STATS[2 * row + 1] = rstd; }
}
__device__ __forceinline__ void gm_spatial_pass(const float* const* in, unsigned char* ws, LAS unsigned char* lds, int bid, int G, int tid) {
    const bf16_t* Z = (const bf16_t*)(ws + WS_BIG); const float* PART = (const float*)(ws + WS_PART); const bf16_t* WSP = (const bf16_t*)(ws + WS_WSP);
    bf16_t* A2 = (bf16_t*)(ws + WS_A2);
    const float* vg = in[22]; const float* vb = in[23]; const float* bsp = in[25];
    LAS bf16_t* VT = (LAS bf16_t*)lds;
    const int lane = tid & 63, wave = __builtin_amdgcn_readfirstlane(tid >> 6), quad = lane >> 4, l15 = lane & 15;
    const int q = tid >> 2, seg = (tid & 3) * 32;
    constexpr int NT = 128 * 16;
    u32x4 vr[4], vrA[4], vrB[4]; f32x4 pr[4], prA[4], prB[4];
    const int ptok = 16 * wave + l15; int cur_g = -1; bf16x8 bw[4]; float bias = 0.f; f32x4 vgr[8], vbr[8]; u32x2 uwv[8];
#define GM_LOAD(tt_) do { const int g_ = (tt_) & 15; const size_t row_ = (size_t)((tt_) >> 4) * 128 + q; const bf16_t* vp_ = Z + row_ * 4096 + 2048 + g_ * 128 + seg; const float* pp_ = PART + row_ * 64 + (tid & 3) * 16; \
        _Pragma("unroll") for (int k = 0; k < 4; ++k) { vrB[k] = *(const u32x4*)(vp_ + 8 * k); prB[k] = *(const f32x4*)(pp_ + 4 * k); } \
        const bf16_t* up_ = Z + ((size_t)((tt_) >> 4) * 128 + ptok) * 4096 + g_ * 128; \
        _Pragma("unroll") for (int dt = 0; dt < 8; ++dt) uwB[dt] = *(const u32x2*)(up_ + 16 * dt + quad * 4); } while (0)
    u32x2 uwA[8], uwB[8];
#define GM_ROT() do { _Pragma("unroll") for (int k = 0; k < 4; ++k) { vrA[k] = vrB[k]; prA[k] = prB[k]; } _Pragma("unroll") for (int dt = 0; dt < 8; ++dt) uwA[dt] = uwB[dt]; } while (0)
    if (bid < NT) { GM_LOAD(bid); GM_ROT(); }
    if (bid + G < NT) GM_LOAD(bid + G);
    for (int t = bid; t < NT; t += G) {
        const int g = t & 15; const size_t r0 = (size_t)(t >> 4) * 128;
#pragma unroll
        for (int k = 0; k < 4; ++k) { vr[k] = vrA[k]; pr[k] = prA[k]; }
        if (g != cur_g) {
#pragma unroll
            for (int k = 0; k < 8; ++k) { vgr[k] = *(const f32x4*)(vg + g * 128 + seg + 4 * k); vbr[k] = *(const f32x4*)(vb + g * 128 + seg + 4 * k); }
        }
#pragma unroll
        for (int dt = 0; dt < 8; ++dt) uwv[dt] = uwA[dt];
        GM_ROT();
        {
            float s1 = 0.f, s2 = 0.f;
#pragma unroll
            for (int k = 0; k < 4; ++k) { s1 += pr[k][0] + pr[k][2]; s2 += pr[k][1] + pr[k][3]; }
            s1 += __shfl_xor(s1, 1); s1 += __shfl_xor(s1, 2); s2 += __shfl_xor(s2, 1); s2 += __shfl_xor(s2, 2);
            const float mean = s1 * (1.0f / 2048.0f), rstd = rsqrtf(fmaxf(s2 * (1.0f / 2048.0f) - mean * mean, 0.f) + EPS);
#pragma unroll
            for (int k = 0; k < 4; ++k) { const u32x4 w = vr[k];
#pragma unroll
                for (int e = 0; e < 4; ++e) { const int d = seg + 8 * k + 2 * e;
                    const float a = (__uint_as_float(w[e] << 16) - mean) * rstd * vgr[2 * k + (e >> 1)][(2 * e) & 3] + vbr[2 * k + (e >> 1)][(2 * e) & 3], bq = (__uint_as_float(w[e] & 0xffff0000u) - mean) * rstd * vgr[2 * k + (e >> 1)][((2 * e) & 3) + 1] + vbr[2 * k + (e >> 1)][((2 * e) & 3) + 1];
                    const unsigned pk = pk2(a, bq); VT[d * 136 + q] = (bf16_t)(pk & 0xffffu); VT[(d + 1) * 136 + q] = (bf16_t)(pk >> 16); } }
        }
        __syncthreads();
        if (t + 2 * G < NT) GM_LOAD(t + 2 * G);
        if (g != cur_g) { cur_g = g;
#pragma unroll
            for (int ks = 0; ks < 4; ++ks) bw[ks] = *(const bf16x8*)(WSP + ((size_t)g * 128 + ptok) * 128 + 32 * ks + quad * 8);
            bias = bsp[g * 128 + ptok]; }
        bf16_t* op = A2 + (r0 + ptok) * DM + g * 128;
#pragma unroll
        for (int dt = 0; dt < 8; ++dt) {
            f32x4 acc = {0.f, 0.f, 0.f, 0.f};
#pragma unroll
            for (int ks = 0; ks < 4; ++ks) { const bf16x8 av = *(const LAS bf16x8*)(VT + (16 * dt + l15) * 136 + 32 * ks + quad * 8); acc = __builtin_amdgcn_mfma_f32_16x16x32_bf16(av, bw[ks], acc, 0, 0, 0); }
            const int d0 = 16 * dt + quad * 4; const u32x2 uw = uwv[dt];
            const float u0 = __uint_as_float(uw.x << 16), u1 = __uint_as_float(uw.x & 0xffff0000u), u2 = __uint_as_float(uw.y << 16), u3 = __uint_as_float(uw.y & 0xffff0000u);
            u32x2 o; o.x = pk2(u0 * (acc[0] + bias), u1 * (acc[1] + bias)); o.y = pk2(u2 * (acc[2] + bias), u3 * (acc[3] + bias));
            *(u32x2*)(op + d0) = o;
        }
        __syncthreads();
    }
#undef GM_LOAD
#undef GM_ROT
}

#define XB_TMO      128
#define XB_XCNT(j)  (256  + 64 * (j))
#define XB_XSUB(j)  (1280 + 64 * (j))
#define XB_XGEN(j)  (2304 + 64 * (j))
#define XB_TOP      3328
#define XB_TOPGEN   3392
#define XCD_BAR_WORDS 3456
#define XB_SPIN_CAP (1u << 18)

__device__ __forceinline__ unsigned xb_ld(unsigned* p)              { return __hip_atomic_load(p, __ATOMIC_RELAXED, __HIP_MEMORY_SCOPE_AGENT); }
__device__ __forceinline__ unsigned xb_add(unsigned* p, unsigned v) { return __hip_atomic_fetch_add(p, v, __ATOMIC_RELAXED, __HIP_MEMORY_SCOPE_AGENT); }
__device__ __forceinline__ unsigned xb_xcc_id() { return (unsigned)__builtin_amdgcn_s_getreg((3 << 11) | 20) & 0xFu; }
#define XB_SPIN(cond, bar) do { unsigned _sp = 0; while (cond) { __builtin_amdgcn_s_sleep(1); \
    if ((++_sp & 255u) == 0u) { if (xb_ld(&(bar)[XB_TMO])) break; if (_sp > XB_SPIN_CAP) { atomicAdd(&(bar)[XB_TMO], 1u); break; } } } } while (0)

struct XcdBarrier {
    unsigned* bar; unsigned x;
    volatile LAS unsigned* st;
};

__device__ __forceinline__ XcdBarrier xcd_barrier_post(unsigned* bar, volatile LAS unsigned* st) {
    XcdBarrier b; b.bar = bar; b.x = xb_xcc_id(); b.st = st;
    if (threadIdx.x == 0) (void)xb_add(&bar[XB_XCNT(b.x)], 1u);
    return b;
}
__device__ __forceinline__ void xcd_barrier_complete(unsigned* bar, unsigned x, unsigned& nloc, unsigned& nx) {
    const unsigned G = gridDim.x * gridDim.y * gridDim.z;
    unsigned sum, cnt, mine, sp = 0u;
    for (;;) {
        sum = 0u; cnt = 0u; mine = 0u;
#pragma unroll
        for (unsigned j = 0; j < 16; ++j) { const unsigned c = xb_ld(&bar[XB_XCNT(j)]); sum += c; cnt += (c > 0u) ? 1u : 0u; mine = (j == x) ? c : mine; }
        if (sum == G) break;
        __builtin_amdgcn_s_sleep(1);
        if ((++sp & 255u) == 0u) { if (xb_ld(&bar[XB_TMO])) break; if (sp > XB_SPIN_CAP) { atomicAdd(&bar[XB_TMO], 1u); break; } }
    }
    nloc = mine > 0u ? mine : 1u; nx = cnt > 0u ? cnt : 1u;
}

__device__ __forceinline__ void xcd_barrier(const XcdBarrier& b) {
    asm volatile("s_waitcnt vmcnt(0)" ::: "memory");
    __syncthreads();
    if (threadIdx.x == 0) {
        unsigned* bar = b.bar;
        __builtin_amdgcn_s_waitcnt(0);
        unsigned nloc = b.st[0], nx = b.st[1];
        if (nloc == 0u) { xcd_barrier_complete(bar, b.x, nloc, nx); b.st[0] = nloc; b.st[1] = nx; }
        const unsigned old = xb_add(&bar[XB_XSUB(b.x)], 1u);
        const unsigned gen = old / nloc;
        if (old + 1u == (gen + 1u) * nloc) {
            __builtin_amdgcn_fence(__ATOMIC_RELEASE, "agent");
            asm volatile("s_waitcnt vmcnt(0)" ::: "memory");
            const unsigned og = xb_add(&bar[XB_TOP], 1u);
            const unsigned tg = og / nx;
            if (og + 1u == (tg + 1u) * nx) xb_add(&bar[XB_TOPGEN], 1u);
            else XB_SPIN(xb_ld(&bar[XB_TOPGEN]) == tg, bar);
            __builtin_amdgcn_fence(__ATOMIC_ACQUIRE, "agent");
            xb_add(&bar[XB_XGEN(b.x)], 1u);
            asm volatile("s_waitcnt vmcnt(0)" ::: "memory");
        } else {
            XB_SPIN(xb_ld(&bar[XB_XGEN(b.x)]) == gen, bar);
            __builtin_amdgcn_fence(__ATOMIC_ACQUIRE, "agent");
            asm volatile("s_waitcnt vmcnt(0)" ::: "memory");
        }
    }
    __syncthreads();
}

__global__ void __launch_bounds__(NTHREADS) mega(Params P) {
    extern __shared__ __attribute__((aligned(16))) unsigned char lds_raw[];
    cg::grid_group grid = cg::this_grid();
    LAS unsigned char* lds = (LAS unsigned char*)lds_raw;
    const int tid = threadIdx.x, lane = tid & 63, wave = __builtin_amdgcn_readfirstlane(tid >> 6), bid = blockIdx.x, G = gridDim.x;
    const int gw = bid * 8 + wave, NGW = G * 8;
    unsigned char* ws = P.ws;
    volatile LAS unsigned* MISC = (volatile LAS unsigned*)(lds + LDS_BYTES - 16);
    if (tid < 4) MISC[tid] = 0u;
    __syncthreads();
    float* XB = (float*)(ws + WS_STATS);
    unsigned* BAR = (unsigned*)(ws + WS_CNT + 262144);
    const int lo = P.ph_lo, hi = P.ph_hi;
    const float* x = P.in[0]; const float* ctx = P.in[2]; const float* normg = P.in[6];
    float* MOD = (float*)(ws + WS_MOD);
    bf16_t* XL = (bf16_t*)(ws + WS_XL);
    unsigned* CNT = (unsigned*)(ws + WS_CNT);
    bf16_t* H = (bf16_t*)(ws + WS_H); bf16_t* BIG = (bf16_t*)(ws + WS_BIG); bf16_t* A2 = (bf16_t*)(ws + WS_A2); bf16_t* OL = (bf16_t*)(ws + WS_OL);
#ifndef REPMASK
#define REPMASK 0
#endif
#define IN(k) (lo <= (k) && (k) < hi)
#define REP(k) _Pragma("unroll") for (int rep_ = 0; rep_ <= ((REPMASK >> (k)) & 1); ++rep_)
#define SEAM(k) do { if (IN(k)) xcd_barrier(xbar); } while (0)
#define MODP(layer, r, slot) (MOD + (size_t)((layer) * 5 + (r)) * NMOD + (slot) * DM)
#define NG(layer, k) (normg + ((layer) * 4 + (k)) * DM)

    if (IN(0)) REP(0) {
        for (int i = bid * NTHREADS + tid; i < 8 * 4096; i += G * NTHREADS) CNT[i] = 0u;
        if (bid == 0) for (int i = tid; i < XCD_BAR_WORDS; i += NTHREADS) BAR[i] = 0u;
        p0_mod(P.in[1], P.in[3], P.in[4], P.in[5], MOD, lds, bid, G, tid);
        __syncthreads();
        p0_weights(P.in, ws, lds, bid, G, tid);
        __syncthreads();
    }
    grid.sync();
    const XcdBarrier xbar = xcd_barrier_post(BAR, MISC);
    if (IN(1)) REP(1) {
        for (int row = gw; row < MT; row += NGW) {
            const int b_ = row / TKV, pos = row % TKV; const bool latent = pos >= CTX; const int r = latent ? b_ : 4;
            const float* res = latent ? x + (size_t)(b_ * SEQ + pos - CTX) * DM : ctx + (size_t)(b_ * CTX + pos) * DM;
            row_op<false, false>(res, nullptr, nullptr, nullptr, nullptr, NG(0, 0), MODP(0, r, 0), MODP(0, r, 1), H + (size_t)row * DM, lane);
        }
    }
    SEAM(1);
    if (IN(2)) REP(2) {
        pg8::Gemm g{H, (const bf16_t*)(ws + WS_WIN), MT, AR_IN, DM}; pg8::StaticOrder S; S.init(MT, AR_IN, G, bid);
        pg8::EpiAct<0> E{BIG, AR_IN, nullptr};
        pg8::gemm_phase<pg8::EpiAct<0>, pg8::StaticOrder, true, true>(lds, g, S, E);
    }
    SEAM(2);
    if (IN(3)) REP(3) {
        if (rep_ == 0) { if (G == 256) { if (bid >= 64) k_post(BIG, P.in[11], (bid - 64) * 8 + wave, 192 * 8, lane); } else k_post(BIG, P.in[11], gw, NGW, lane); }
        __syncthreads();
        rglru_pass<1>(P.in, ws, lds, bid, G, tid);
    }
    SEAM(3);
    if (IN(4)) {
        rglru_carry(ws, bid * NTHREADS + tid);
        xcd_barrier(xbar);
        for (int u = bid; u < 512; u += G) {
            const int bv = u & 255, jj = u >> 8, combo = bv & 7, local = bv >> 3, b = combo >> 1, kvh = combo & 1, idx = local * 2 + jj, hig = idx >> 4, qb = idx & 15, h = kvh * 4 + hig;
            att::q_prep<att::bf16>((att::bf16*)BIG + (size_t)(b * TKV + CTX + qb * 256) * AR_IN + h * 128, P.in[10], qb * 256);
        }
        for (int u0 = bid; u0 < 512 * (((REPMASK >> 4) & 1) + 1); u0 += G) { const int u = u0 & 511;
            const int bv = u & 255, jj = u >> 8, combo = bv & 7, local = bv >> 3, b = combo >> 1, kvh = combo & 1, idx = local * 2 + jj, hig = idx >> 4, qb = idx & 15, h = kvh * 4 + hig;
            const att::bf16* Qb = (const att::bf16*)BIG + (size_t)(b * TKV + CTX + qb * 256) * AR_IN + h * 128;
            const att::bf16* Kh = (const att::bf16*)BIG + (size_t)b * TKV * AR_IN + 1024 + kvh * 128; const att::bf16* Vh = (const att::bf16*)BIG + (size_t)b * TKV * AR_IN + 1280 + kvh * 128;
            att::bf16* Ob = (att::bf16*)A2 + (size_t)(b * SEQ + qb * 256) * DM + h * 128;
            att::attn_dense_body<att::bf16>(Qb, Kh, Vh, Ob, TKV, (char*)lds_raw, P.in[10], qb * 256);
            __syncthreads();
        }
        _Pragma("unroll") for (int r2_ = 0; r2_ <= ((REPMASK >> 18) & 1); ++r2_) rglru_pass2(ws, lds, bid, G, tid);
    }
    SEAM(4);
    if (IN(5)) {
        pg8::Gemm g{A2, (const bf16_t*)(ws + WS_WOUT), ML, DM, DM}; PanelOrder S{bid, G};
        EpiPanelReg<false, true> E{{XB, CNT + 0 * 4096}, {XB + 131072, CNT + 1 * 4096}, lds + 131072, x, NG(0, 1), MODP(0, 0, 2), XL, NG(0, 2), MODP(0, 0, 3), MODP(0, 0, 4), H};
        pg8::gemm_phase<EpiPanelReg<false, true>, PanelOrder, true, true>(lds, g, S, E);
    }
    SEAM(5);
    if (IN(7)) REP(7) {
        pg8::Gemm g{H, (const bf16_t*)(ws + WS_WFF1), ML, DFF, DM}; pg8::StaticOrder S; S.init(ML, DFF, G, bid);
        pg8::EpiAct<2> E{BIG, DFF, nullptr};
        pg8::gemm_phase<pg8::EpiAct<2>, pg8::StaticOrder, true, true>(lds, g, S, E);
    }
    SEAM(7);
    if (IN(8)) {
        pg8::Gemm g{BIG, (const bf16_t*)(ws + WS_WFF2), ML, DM, DFF}; PanelOrder S{bid, G};
        EpiPanelReg<true, true> E{{XB, CNT + 2 * 4096}, {XB + 131072, CNT + 3 * 4096}, lds + 131072, XL, NG(0, 3), MODP(0, 0, 5), XL, NG(1, 0), MODP(1, 0, 0), MODP(1, 0, 1), H};
        pg8::gemm_phase<EpiPanelReg<true, true>, PanelOrder, true, true>(lds, g, S, E);
    }
    SEAM(8);
    if (IN(10)) REP(10) {
        pg8::Gemm g{H, (const bf16_t*)(ws + WS_WGIN), ML, 4096, DM}; pg8::StaticOrder S; S.init(ML, 4096, G, bid);
        pg8::EpiAct<3> E{BIG, 4096, P.in[21], (float*)(ws + WS_PART)};
        pg8::gemm_phase<pg8::EpiAct<3>, pg8::StaticOrder, true, true>(lds, g, S, E);
    }
    SEAM(10);
    if (IN(12)) REP(12) { gm_spatial_pass(P.in, ws, lds, bid, G, tid); }
    SEAM(12);
    if (IN(13)) {
        pg8::Gemm g{A2, (const bf16_t*)(ws + WS_WGOUT), ML, DM, DM}; PanelOrder S{bid, G};
        EpiPanelReg<true, true> E{{XB, CNT + 4 * 4096}, {XB + 131072, CNT + 5 * 4096}, lds + 131072, XL, NG(1, 1), MODP(1, 0, 2), XL, NG(1, 2), MODP(1, 0, 3), MODP(1, 0, 4), H};
        pg8::gemm_phase<EpiPanelReg<true, true>, PanelOrder, true, true>(lds, g, S, E);
    }
    SEAM(13);
    if (IN(15)) REP(15) {
        pg8::Gemm g{H, (const bf16_t*)(ws + WS_WFF1) + (size_t)DM * DFF, ML, DFF, DM}; pg8::StaticOrder S; S.init(ML, DFF, G, bid);
        pg8::EpiAct<2> E{BIG, DFF, nullptr};
        pg8::gemm_phase<pg8::EpiAct<2>, pg8::StaticOrder, true, true>(lds, g, S, E);
    }
    SEAM(15);
    if (IN(16)) {
        pg8::Gemm g{BIG, (const bf16_t*)(ws + WS_WFF2) + (size_t)DM * DFF, ML, DM, DFF}; PanelOrder S{bid, G};
        EpiPanelReg<true, false> E{{XB, CNT + 6 * 4096}, {XB + 131072, CNT + 7 * 4096}, lds + 131072, XL, NG(1, 3), MODP(1, 0, 5), P.out, nullptr, nullptr, nullptr, nullptr};
        pg8::gemm_phase<EpiPanelReg<true, false>, PanelOrder, true, true>(lds, g, S, E);
    }
}

constexpr int NPHASE = 18;
#ifndef MK_PER_PHASE
#define MK_PER_PHASE 0
#endif
extern "C" void kernel_launch(void* const* d_in, const int* in_sizes, int n_in, void* d_out, int out_size, void* d_ws, size_t ws_size, hipStream_t stream) {
    static int grid = 0;
    if (grid == 0) {
        if (n_in != 27 || in_sizes[0] != ML * DM || out_size != ML * DM || ws_size < WS_END) { fprintf(stderr, "kernel_launch: unexpected shapes / workspace (n_in %d, ws %zu < %zu)\n", n_in, ws_size, (size_t)WS_END); grid = -1; return; }
        int dev = 0, cus = 0, per_cu = 0;
        if (hipGetDevice(&dev) != hipSuccess || hipDeviceGetAttribute(&cus, hipDeviceAttributeMultiprocessorCount, dev) != hipSuccess) { grid = -1; return; }
        if (hipFuncSetAttribute((const void*)mega, hipFuncAttributeMaxDynamicSharedMemorySize, LDS_BYTES) != hipSuccess) { fprintf(stderr, "kernel_launch: hipFuncSetAttribute failed\n"); grid = -1; return; }
        if (hipOccupancyMaxActiveBlocksPerMultiprocessor(&per_cu, (const void*)mega, NTHREADS, LDS_BYTES) != hipSuccess || per_cu < 1) { fprintf(stderr, "kernel_launch: occupancy query says %d\n", per_cu); per_cu = 1; }
        (void)hipGetLastError();
        grid = cus * 1;
    }
    if (grid < 0) return;
    Params p{};
    for (int i = 0; i < 27; ++i) p.in[i] = (const float*)d_in[i];
    p.out = (float*)d_out; p.ws = (unsigned char*)d_ws;
#if MK_PER_PHASE
    for (int ph = 0; ph < NPHASE; ++ph) { p.ph_lo = ph; p.ph_hi = ph + 1; hipLaunchKernelGGL(mega, dim3(grid), dim3(NTHREADS), LDS_BYTES, stream, p); }
#else
    p.ph_lo = 0; p.ph_hi = NPHASE;
    void* args[] = {&p};
    hipError_t e = hipLaunchCooperativeKernel((const void*)mega, dim3(grid), dim3(NTHREADS), args, LDS_BYTES, stream);
    if (e != hipSuccess) fprintf(stderr, "kernel_launch: cooperative launch failed: %s (grid %d)\n", hipGetErrorString(e), grid);
#endif
}
```
